# Optimizing an MI355X kernel written in HIP

```python
import jax, jax.numpy as jnp
from jax import lax
import numpy as np

D_MODEL = 1024
BATCH = 8
SEQ = 4096
DEPTH = 1

D_MIX = 1024
GDN_HEADS = 4
GDN_DK = 128
GDN_DV = 128
GDN_CONV = 4
GDN_CHUNK = 64
RWKV_HEADS = 8
RWKV_N = 64
LORA_W = 64
LORA_A = 64
LORA_G = 128
D_FF = 2816
D_PLE = 256
NORM_EPS = 1e-6
GN_EPS = 64e-5
L2_EPS = 1e-6

GDN_QK_W = GDN_HEADS * GDN_DK
GDN_W = GDN_HEADS * GDN_DV
GDN_CONV_COLS = 2 * GDN_QK_W + GDN_W
GDN_COLS = GDN_CONV_COLS + GDN_W + 2 * GDN_HEADS
RWKV_W = RWKV_HEADS * RWKV_N
RWKV_COLS = 3 * RWKV_W + LORA_W + LORA_A + LORA_G
IN_COLS = GDN_COLS + RWKV_COLS

kernel_name = 'hybrid_gdn_rwkv7_macaron_block'


def rmsnorm(x, g):
    xf = x.astype(jnp.float32)
    y = xf * lax.rsqrt(jnp.mean(xf * xf, axis=-1, keepdims=True) + NORM_EPS)
    return (y * g.astype(jnp.float32)).astype(x.dtype)


def l2norm(x):
    return x * lax.rsqrt(jnp.sum(x * x, axis=-1, keepdims=True) + L2_EPS)


def swiglu(x, w_gate, w_up, w_down):
    return (jax.nn.silu(x @ w_gate) * (x @ w_up)) @ w_down


def causal_depthwise_conv(x, w):
    k = w.shape[0]
    return lax.conv_general_dilated(
        x, w[:, None, :].astype(x.dtype), window_strides=(1,), padding=((k - 1, 0),),
        dimension_numbers=('NWC', 'WIO', 'NWC'), feature_group_count=x.shape[-1])


def to_chunks(t, n_chunks):
    b, _, h = t.shape[:3]
    t = t.reshape(b, n_chunks, GDN_CHUNK, h, *t.shape[3:])
    return jnp.moveaxis(t, 3, 1)


def gated_delta_rule_chunked(q, k, v, g, beta):
    b, t, h, dk = q.shape
    dv = v.shape[-1]
    nc = t // GDN_CHUNK
    q = to_chunks(q * dk ** -0.5, nc)
    k = to_chunks(k, nc)
    v = to_chunks(v, nc)
    g = to_chunks(g, nc)
    beta = to_chunks(beta, nc)
    gc = jnp.cumsum(g, axis=-1)
    idx = jnp.arange(GDN_CHUNK)
    causal = idx[:, None] >= idx[None, :]
    strict = idx[:, None] > idx[None, :]
    decay = jnp.where(causal, jnp.exp(jnp.where(causal, gc[..., :, None] - gc[..., None, :], 0.0)), 0.0)
    kb = k * beta[..., None]
    vb = v * beta[..., None]
    lmat = jnp.where(strict, jnp.einsum('bhnid,bhnjd->bhnij', kb, k) * decay, 0.0)
    eye = jnp.eye(GDN_CHUNK, dtype=jnp.float32)
    tinv = lax.linalg.triangular_solve(eye + lmat, jnp.broadcast_to(eye, lmat.shape),
                                       left_side=True, lower=True, unit_diagonal=True)
    u = tinv @ vb
    wk = tinv @ (kb * jnp.exp(gc)[..., None])
    a_qk = jnp.einsum('bhnid,bhnjd->bhnij', q, k) * decay
    q_dec = q * jnp.exp(gc)[..., None]
    k_dec = k * jnp.exp(gc[..., -1:] - gc)[..., None]
    g_last = jnp.exp(gc[..., -1])
    xs = tuple(jnp.moveaxis(a, 2, 0) for a in (u, wk, q_dec, a_qk, k_dec, g_last))

    def step(state, inp):
        u_n, w_n, q_n, a_n, k_n, gl_n = inp
        v_new = u_n - w_n @ state
        o_n = q_n @ state + a_n @ v_new
        state = state * gl_n[..., None, None] + jnp.swapaxes(k_n, -1, -2) @ v_new
        return state, o_n

    s0 = jnp.zeros((b, h, dk, dv), jnp.float32)
    _, o = lax.scan(step, s0, xs)
    return jnp.transpose(o, (1, 0, 3, 2, 4)).reshape(b, t, h, dv)


def rwkv7_scan(r, w, k, v, kk, a):
    b, _, h, n = r.shape
    xs = tuple(jnp.moveaxis(t, 1, 0) for t in (r, w, k, v, kk, a))

    def step(state, inp):
        r_t, w_t, k_t, v_t, kk_t, a_t = inp
        sa = jnp.einsum('bhvk,bhk->bhv', state, -kk_t)
        state = (state * w_t[:, :, None, :] + sa[..., None] * (kk_t * a_t)[:, :, None, :]
                 + v_t[..., None] * k_t[:, :, None, :])
        y = jnp.einsum('bhvk,bhk->bhv', state, r_t)
        return state, y

    s0 = jnp.zeros((b, h, n, n), jnp.float32)
    _, y = lax.scan(step, s0, xs)
    return jnp.moveaxis(y, 0, 1)


def hybrid_mixer(h, w_in, conv_w, a_log, dt_bias, gdn_norm_w, mu, w0, w2, a0, a2, g2,
                 k_k, k_a, r_k, gn_w, gn_b, w_out):
    b, t, _ = h.shape
    f32 = jnp.float32
    proj = (h @ w_in).astype(f32)

    gdn = proj[..., :GDN_COLS]
    qkv = jax.nn.silu(causal_depthwise_conv(gdn[..., :GDN_CONV_COLS], conv_w.astype(f32)))
    q = l2norm(qkv[..., :GDN_QK_W].reshape(b, t, GDN_HEADS, GDN_DK))
    k = l2norm(qkv[..., GDN_QK_W:2 * GDN_QK_W].reshape(b, t, GDN_HEADS, GDN_DK))
    v = qkv[..., 2 * GDN_QK_W:].reshape(b, t, GDN_HEADS, GDN_DV)
    z = gdn[..., GDN_CONV_COLS:GDN_CONV_COLS + GDN_W].reshape(b, t, GDN_HEADS, GDN_DV)
    off = GDN_CONV_COLS + GDN_W
    beta = jax.nn.sigmoid(gdn[..., off:off + GDN_HEADS])
    g = -jnp.exp(a_log.astype(f32)) * jax.nn.softplus(gdn[..., off + GDN_HEADS:] + dt_bias.astype(f32))
    o = gated_delta_rule_chunked(q, k, v, g, beta)
    o = rmsnorm(o, gdn_norm_w) * jax.nn.silu(z)
    y_gdn = o.reshape(b, t, GDN_W)

    rw = proj[..., GDN_COLS:]
    prev = jnp.pad(rw, ((0, 0), (1, 0), (0, 0)))[:, :-1]
    xs = rw + (prev - rw) * mu.astype(f32)
    r = xs[..., :RWKV_W]
    kr = xs[..., RWKV_W:2 * RWKV_W]
    vr = xs[..., 2 * RWKV_W:3 * RWKV_W]
    off = 3 * RWKV_W
    lw = xs[..., off:off + LORA_W]
    la = xs[..., off + LORA_W:off + LORA_W + LORA_A]
    lg = xs[..., off + LORA_W + LORA_A:]
    w_log = -jax.nn.softplus(-(w0.astype(f32) + jnp.tanh(lw) @ w2.astype(f32))) - 0.5
    decay = jnp.exp(-jnp.exp(w_log))
    a = jax.nn.sigmoid(a0.astype(f32) + la @ a2.astype(f32))
    gate = jax.nn.sigmoid(lg) @ g2.astype(f32)
    hs = (b, t, RWKV_HEADS, RWKV_N)
    r, kr, vr, a, decay = (u.reshape(hs) for u in (r, kr, vr, a, decay))
    kk = l2norm(kr * k_k.astype(f32).reshape(RWKV_HEADS, RWKV_N))
    kr = kr * (1.0 + (a - 1.0) * k_a.astype(f32).reshape(RWKV_HEADS, RWKV_N))
    y = rwkv7_scan(r, decay, kr, vr, kk, a)
    mean = jnp.mean(y, axis=-1, keepdims=True)
    var = jnp.mean(jnp.square(y - mean), axis=-1, keepdims=True)
    y = ((y - mean) * lax.rsqrt(var + GN_EPS) * gn_w.astype(f32).reshape(RWKV_HEADS, RWKV_N)
         + gn_b.astype(f32).reshape(RWKV_HEADS, RWKV_N))
    y = y + jnp.sum(r * kr * r_k.astype(f32), axis=-1, keepdims=True) * vr
    y_rwkv = y.reshape(b, t, RWKV_W) * gate

    merged = jnp.concatenate([y_gdn, y_rwkv], axis=-1).astype(h.dtype)
    return merged @ w_out


def setup_inputs(seed: int = 0) -> dict:
    key = jax.random.key(seed)
    ks = list(jax.random.split(key, 40))
    f32 = jnp.float32

    def nrm(shape, scale):
        return jax.random.normal(ks.pop(), shape, f32) * scale

    def gain(n):
        return 1.0 + 0.02 * jax.random.normal(ks.pop(), (DEPTH, n), f32)

    def unif(shape, lo, hi):
        return jax.random.uniform(ks.pop(), shape, f32, minval=lo, maxval=hi)

    dt = jnp.exp(unif((DEPTH, GDN_HEADS), float(np.log(1e-3)), float(np.log(1e-1))))
    inp = {}
    inp['x'] = nrm((BATCH, SEQ, D_MODEL), 1.0)
    inp['p'] = nrm((DEPTH, BATCH, SEQ, D_PLE), 1.0)
    inp['ffn1_norm_pre'] = gain(D_MODEL)
    inp['ffn1_w_gate'] = nrm((DEPTH, D_MODEL, D_FF), D_MODEL ** -0.5)
    inp['ffn1_w_up'] = nrm((DEPTH, D_MODEL, D_FF), D_MODEL ** -0.5)
    inp['ffn1_w_down'] = nrm((DEPTH, D_FF, D_MODEL), D_FF ** -0.5)
    inp['ffn1_norm_post'] = gain(D_MODEL)
    inp['mix_norm_pre'] = gain(D_MODEL)
    inp['w_in'] = nrm((DEPTH, D_MODEL, IN_COLS), D_MODEL ** -0.5)
    inp['gdn_conv_w'] = nrm((DEPTH, GDN_CONV, GDN_CONV_COLS), GDN_CONV ** -0.5)
    inp['gdn_a_log'] = jnp.log(unif((DEPTH, GDN_HEADS), 1.0, 16.0))
    inp['gdn_dt_bias'] = dt + jnp.log(-jnp.expm1(-dt))
    inp['gdn_norm_w'] = gain(GDN_DV)
    inp['rwkv_mu'] = unif((DEPTH, RWKV_COLS), 0.0, 1.0)
    inp['rwkv_w0'] = unif((DEPTH, RWKV_W), -6.0, 1.0)
    inp['rwkv_w2'] = nrm((DEPTH, LORA_W, RWKV_W), LORA_W ** -0.5)
    inp['rwkv_a0'] = nrm((DEPTH, RWKV_W), 0.5)
    inp['rwkv_a2'] = nrm((DEPTH, LORA_A, RWKV_W), LORA_A ** -0.5)
    inp['rwkv_g2'] = nrm((DEPTH, LORA_G, RWKV_W), LORA_G ** -0.5)
    inp['rwkv_k_k'] = 0.85 + nrm((DEPTH, RWKV_W), 0.05)
    inp['rwkv_k_a'] = 1.0 + nrm((DEPTH, RWKV_W), 0.05)
    inp['rwkv_r_k'] = nrm((DEPTH, RWKV_HEADS, RWKV_N), 0.1)
    inp['rwkv_gn_w'] = gain(RWKV_W)
    inp['rwkv_gn_b'] = nrm((DEPTH, RWKV_W), 0.01)
    inp['w_out'] = nrm((DEPTH, D_MIX, D_MODEL), D_MIX ** -0.5)
    inp['mix_norm_post'] = gain(D_MODEL)
    inp['ffn2_norm_pre'] = gain(D_MODEL)
    inp['ffn2_w_gate'] = nrm((DEPTH, D_MODEL, D_FF), D_MODEL ** -0.5)
    inp['ffn2_w_up'] = nrm((DEPTH, D_MODEL, D_FF), D_MODEL ** -0.5)
    inp['ffn2_w_down'] = nrm((DEPTH, D_FF, D_MODEL), D_FF ** -0.5)
    inp['ffn2_norm_post'] = gain(D_MODEL)
    inp['ple_norm_pre'] = gain(D_MODEL)
    inp['ple_w_gate'] = nrm((DEPTH, D_MODEL, D_MODEL), D_MODEL ** -0.5)
    inp['ple_w_proj'] = nrm((DEPTH, D_PLE, D_MODEL), D_PLE ** -0.5)
    inp['ple_norm_post'] = gain(D_MODEL)
    return inp


def reference(x, p, ffn1_norm_pre, ffn1_w_gate, ffn1_w_up, ffn1_w_down, ffn1_norm_post,
              mix_norm_pre, w_in, gdn_conv_w, gdn_a_log, gdn_dt_bias, gdn_norm_w,
              rwkv_mu, rwkv_w0, rwkv_w2, rwkv_a0, rwkv_a2, rwkv_g2, rwkv_k_k, rwkv_k_a, rwkv_r_k,
              rwkv_gn_w, rwkv_gn_b, w_out, mix_norm_post,
              ffn2_norm_pre, ffn2_w_gate, ffn2_w_up, ffn2_w_down, ffn2_norm_post,
              ple_norm_pre, ple_w_gate, ple_w_proj, ple_norm_post):
    for i in range(DEPTH):
        f = swiglu(rmsnorm(x, ffn1_norm_pre[i]), ffn1_w_gate[i], ffn1_w_up[i], ffn1_w_down[i])
        x = x + 0.5 * rmsnorm(f, ffn1_norm_post[i])
        m = hybrid_mixer(rmsnorm(x, mix_norm_pre[i]), w_in[i], gdn_conv_w[i], gdn_a_log[i],
                         gdn_dt_bias[i], gdn_norm_w[i], rwkv_mu[i], rwkv_w0[i], rwkv_w2[i],
                         rwkv_a0[i], rwkv_a2[i], rwkv_g2[i], rwkv_k_k[i], rwkv_k_a[i], rwkv_r_k[i],
                         rwkv_gn_w[i], rwkv_gn_b[i], w_out[i])
        x = x + rmsnorm(m, mix_norm_post[i])
        f = swiglu(rmsnorm(x, ffn2_norm_pre[i]), ffn2_w_gate[i], ffn2_w_up[i], ffn2_w_down[i])
        x = x + 0.5 * rmsnorm(f, ffn2_norm_post[i])
        gate = jax.nn.sigmoid(rmsnorm(x, ple_norm_pre[i]) @ ple_w_gate[i])
        x = x + rmsnorm(gate * (p[i] @ ple_w_proj[i]), ple_norm_post[i])
    return x
```

```cpp
#include <hip/hip_runtime.h>
#include <hip/hip_cooperative_groups.h>
#include <cstdio>
#include <cstdint>
namespace cg = cooperative_groups;
namespace pg8 {
#define PG8_LAS __attribute__((address_space(3)))
typedef unsigned short bf16_t;
typedef short bf16x8 __attribute__((ext_vector_type(8)));
typedef float f32x4 __attribute__((ext_vector_type(4)));
typedef unsigned u32x4 __attribute__((ext_vector_type(4)));
constexpr int BM = 256, BK = 64, HALF = 128, HTB = HALF * BK * 2  , STAGE_BYTES = 8 * HTB, NXCD = 8, WGM = 8;

__host__ __device__ __forceinline__ int lds_byte(int r, int c) { const int st = (r >> 4) * 2 + (c >> 5), rr = r & 15, cc = c & 31, ob = rr * 64 + cc * 2; return st * 1024 + (ob ^ (((ob >> 9) & 1) << 5)); }
__host__ __device__ __forceinline__ void stage_rc(int b, int& R, int& C) { const int st = b / 1024, sb = b % 1024, swz = sb ^ (((sb >> 9) & 1) << 5); R = (st >> 1) * 16 + swz / 64; C = (st & 1) * 32 + (swz % 64) / 2; }
__host__ __device__ __forceinline__ int perm32(int rho) { const int n = rho >> 4, i = rho & 15; return 8 * (i >> 2) + 4 * n + (i & 3); }

struct Unit { int pm, pn; };
struct Gemm { const bf16_t* A; const bf16_t* Bt; int M, N, K; };

struct StaticOrder {
    int nM, nN, nwg, G, c;
    __host__ __device__ void init(int M, int N, int G_, int c_) { nM = M / BM; nN = N / BM; nwg = nM * nN; G = G_; c = c_; }
    __host__ __device__ bool next(int i, Unit& u) const {
        const long L = (long)i * G + c; if (L >= nwg) return false;
        int wgid = (int)L; { const int q = nwg / NXCD, r = nwg % NXCD, xcd = wgid % NXCD, off = wgid / NXCD; wgid = (xcd < r ? xcd * (q + 1) : r * (q + 1) + (xcd - r) * q) + off; }
        const int nig = WGM * nN, gid = wgid / nig, fm = gid * WGM, gsz = (nM - fm) < WGM ? (nM - fm) : WGM;
        u.pm = fm + ((wgid % nig) % gsz); u.pn = (wgid % nig) / gsz; return true;
    }
    __device__ __forceinline__ void a_ready(const Unit&) const {}
    __device__ __forceinline__ void done(const Unit&) const {}
};

__device__ __forceinline__ unsigned cvt_pk_bf16(float lo, float hi) { unsigned r; asm volatile("v_cvt_pk_bf16_f32 %0, %1, %2" : "=v"(r) : "v"(lo), "v"(hi)); return r; }
typedef float f32x2 __attribute__((ext_vector_type(2)));
__device__ __forceinline__ f32x2 gelu_pk(f32x2 v) {
    const f32x2 av = __builtin_elementwise_abs(v), d = av * 0.2316418882f + 1.0f;
    f32x2 t; t.x = __builtin_amdgcn_rcpf(d.x); t.y = __builtin_amdgcn_rcpf(d.y);
    f32x2 q = t * 0.5307027145f + (-0.7265760135f); q = q * t + 0.7107068705f; q = q * t + (-0.142248368f); q = q * t + 0.127414796f; q = q * t;
    const f32x2 s = (v * v) * (-0.72134752044f);
    f32x2 e; e.x = __builtin_amdgcn_exp2f(s.x); e.y = __builtin_amdgcn_exp2f(s.y);
    const f32x2 m = v * (q * e), r = v - m;
    f32x2 o; o.x = v.x < 0.f ? m.x : r.x; o.y = v.y < 0.f ? m.y : r.y; return o;
}

template <int ACT  > struct EpiBf16 {
    static constexpr bool PERM = true, AFTER_DRAIN = false; static_assert(ACT == 0 || ACT == 1, "EpiBf16: ACT is 0 (none) or 1 (gelu_pk)");
    bf16_t* O; int ldc; const float* bias; int split_cols; size_t split_stride; float scale0;
    __device__ __forceinline__ void operator()(const f32x4 (&acc)[2][2][4][2], const Unit& u, int wr, int wc, int fr, int fq) const {
        const int row0 = u.pm * BM + wr * 64 + fr; int colt = u.pn * BM; bf16_t* base = O;
        float sc = 1.f; if (split_cols) { const int t = colt / split_cols; base += (size_t)t * split_stride; colt -= t * split_cols; if (t == 0) sc = scale0; }
        const int col0 = colt + wc * 32 + 8 * fq, bcol0 = u.pn * BM + wc * 32 + 8 * fq;
        f32x4 bv[2][2];
#pragma unroll
        for (int bj = 0; bj < 2; ++bj)
#pragma unroll
            for (int n = 0; n < 2; ++n) bv[bj][n] = bias ? *(const f32x4*)(bias + bcol0 + bj * HALF + 4 * n) : (f32x4){0.f, 0.f, 0.f, 0.f};
#pragma unroll
        for (int ai = 0; ai < 2; ++ai)
#pragma unroll
            for (int m = 0; m < 4; ++m) { bf16_t* rowp = base + (size_t)(row0 + ai * HALF + m * 16) * ldc + col0;
#pragma unroll
                for (int bj = 0; bj < 2; ++bj) { f32x4 v0 = acc[ai][bj][m][0] + bv[bj][0], v1 = acc[ai][bj][m][1] + bv[bj][1];
                    if (ACT == 1) { f32x2 a = gelu_pk((f32x2){v0[0], v0[1]}), b = gelu_pk((f32x2){v0[2], v0[3]}), c = gelu_pk((f32x2){v1[0], v1[1]}), d = gelu_pk((f32x2){v1[2], v1[3]});
                        v0 = (f32x4){a.x, a.y, b.x, b.y}; v1 = (f32x4){c.x, c.y, d.x, d.y}; }
                    v0 = v0 * sc; v1 = v1 * sc; u32x4 w; w.x = cvt_pk_bf16(v0[0], v0[1]); w.y = cvt_pk_bf16(v0[2], v0[3]); w.z = cvt_pk_bf16(v1[0], v1[1]); w.w = cvt_pk_bf16(v1[2], v1[3]);
                    *(u32x4*)(rowp + bj * HALF) = w; } }
    }
};
__device__ __forceinline__ int lane_id_opaque() { int l; asm volatile("v_mbcnt_lo_u32_b32 %0, -1, 0\n\tv_mbcnt_hi_u32_b32 %0, -1, %0" : "=v"(l)); return l; }
__device__ __forceinline__ float sigmoid_f(float x) { return __builtin_amdgcn_rcpf(1.f + __expf(-x)); }
struct EpiF32 {
    static constexpr bool PERM = false, AFTER_DRAIN = false;
    float* C; int ldc;
    __device__ __forceinline__ void operator()(const f32x4 (&acc)[2][2][4][2], const Unit& u, int wr, int wc, int fr, int fq) const {
        const int row0 = u.pm * BM + wr * 64 + fr, col0 = u.pn * BM + wc * 32 + 4 * fq;
#pragma unroll
        for (int ai = 0; ai < 2; ++ai)
#pragma unroll
            for (int m = 0; m < 4; ++m) { float* rowp = C + (size_t)(row0 + ai * HALF + m * 16) * ldc + col0;
#pragma unroll
                for (int bj = 0; bj < 2; ++bj)
#pragma unroll
                    for (int n = 0; n < 2; ++n) *(f32x4*)(rowp + bj * HALF + n * 16) = acc[ai][bj][m][n]; }
    }
};
struct EpiSwiglu {
    static constexpr bool PERM = true, AFTER_DRAIN = false;
    bf16_t* O; int ldc;
    __device__ __forceinline__ void operator()(const f32x4 (&acc)[2][2][4][2], const Unit& u, int wr, int wc, int fr, int fq) const {
        const int row0 = u.pm * BM + wr * 64 + fr, col0 = u.pn * HALF + wc * 32 + 8 * fq;
#pragma unroll
        for (int ai = 0; ai < 2; ++ai)
#pragma unroll
            for (int m = 0; m < 4; ++m) { bf16_t* rowp = O + (size_t)(row0 + ai * HALF + m * 16) * ldc + col0;
                f32x4 h0, h1;
#pragma unroll
                for (int e = 0; e < 4; ++e) { const float g0 = acc[ai][0][m][0][e], g1 = acc[ai][0][m][1][e];
                    h0[e] = g0 * sigmoid_f(g0) * acc[ai][1][m][0][e]; h1[e] = g1 * sigmoid_f(g1) * acc[ai][1][m][1][e]; }
                u32x4 w; w.x = cvt_pk_bf16(h0[0], h0[1]); w.y = cvt_pk_bf16(h0[2], h0[3]); w.z = cvt_pk_bf16(h1[0], h1[1]); w.w = cvt_pk_bf16(h1[2], h1[3]);
                *(u32x4*)rowp = w; }
    }
};
struct EpiPle {
    static constexpr bool PERM = false, AFTER_DRAIN = false;
    float* C; const bf16_t* T; int ldc;
    __device__ __forceinline__ void operator()(const f32x4 (&acc)[2][2][4][2], const Unit& u, int wr, int wc, int fr, int fq) const {
        typedef unsigned u32x2 __attribute__((ext_vector_type(2)));
        const int row0 = u.pm * BM + wr * 64 + fr, col0 = u.pn * BM + wc * 32 + 4 * fq;
#pragma unroll
        for (int ai = 0; ai < 2; ++ai)
#pragma unroll
            for (int m = 0; m < 4; ++m) { const size_t off = (size_t)(row0 + ai * HALF + m * 16) * ldc + col0;
#pragma unroll
                for (int bj = 0; bj < 2; ++bj)
#pragma unroll
                    for (int n = 0; n < 2; ++n) { const u32x2 t = *(const u32x2*)(T + off + bj * HALF + n * 16); const f32x4 a = acc[ai][bj][m][n];
                        f32x4 o; o[0] = sigmoid_f(a[0]) * __uint_as_float(t.x << 16); o[1] = sigmoid_f(a[1]) * __uint_as_float(t.x & 0xffff0000u);
                        o[2] = sigmoid_f(a[2]) * __uint_as_float(t.y << 16); o[3] = sigmoid_f(a[3]) * __uint_as_float(t.y & 0xffff0000u);
                        *(f32x4*)(C + off + bj * HALF + n * 16) = o; } }
    }
};
template <class Epi, class Sched, bool ALIGN_EPI = false, bool SP2 = false>
__device__ __forceinline__ void gemm_phase(PG8_LAS unsigned char* lds, const Gemm g, const Sched& S, const Epi& E, int wave_id) {
    int tid_ = wave_id * 64 + lane_id_opaque();
    const int tid = tid_, wid = __builtin_amdgcn_readfirstlane(tid >> 6), lane = tid & 63, wr = wid >> 2, wc = wid & 3, fr = lane & 15, fq = lane >> 4;
    const int K = g.K, nt = K / BK;
    unsigned voffA[2], voffB[2];
#pragma unroll
    for (int i = 0; i < 2; ++i) { int R, C; stage_rc(tid * 16 + i * 8192, R, C); const int Rb = Epi::PERM ? ((R & ~31) + perm32(R & 31)) : R;
        voffA[i] = (unsigned)(R * K + C) * 2u; voffB[i] = (unsigned)(Rb * K + C) * 2u; }
    const size_t kstep = (size_t)(BK * 2);
    const size_t hstep = (size_t)HALF * K * 2;
    const size_t tstep = 2 * hstep;
    const unsigned ldsw = (unsigned)wid * 1024u;
    const int aoff = lds_byte(wr * 64 + fr, fq * 8), boff = lds_byte(wc * 32 + fr, fq * 8);
#define PG8_SA(b, h) (((b) * 2 + (h)) * HTB)
#define PG8_SB(b, h) ((4 + (b) * 2 + (h)) * HTB)
#define PG8_STAGE(bufoff, gbase, voff) do { _Pragma("unroll") for (int _i = 0; _i < 2; ++_i) \
        __builtin_amdgcn_global_load_lds((const unsigned*)((const char*)(gbase) + (voff)[_i]), (PG8_LAS unsigned*)(lds + (bufoff) + ldsw + _i * 8192), 16, 0, 0); } while (0)
#define PG8_LDA(dst, b, h) do { _Pragma("unroll") for (int m = 0; m < 4; ++m) _Pragma("unroll") for (int k = 0; k < 2; ++k) dst[m][k] = *(const PG8_LAS bf16x8*)(lds + PG8_SA(b, h) + aoff + m * 2048 + k * 1024); } while (0)
#define PG8_LDB(dst, b, h) do { _Pragma("unroll") for (int n = 0; n < 2; ++n) _Pragma("unroll") for (int k = 0; k < 2; ++k) dst[n][k] = *(const PG8_LAS bf16x8*)(lds + PG8_SB(b, h) + boff + n * 2048 + k * 1024); } while (0)
#define PG8_MMA(ai, bj, At, Bt) do { __builtin_amdgcn_s_setprio(1); _Pragma("unroll") for (int m = 0; m < 4; ++m) _Pragma("unroll") for (int n = 0; n < 2; ++n) _Pragma("unroll") for (int k = 0; k < 2; ++k) \
        acc[ai][bj][m][n] = __builtin_amdgcn_mfma_f32_16x16x32_bf16(Bt[n][k], At[m][k], acc[ai][bj][m][n], 0, 0, 0); __builtin_amdgcn_s_setprio(0); } while (0)
#define PG8_WAIT_V(n) asm volatile("s_waitcnt vmcnt(" #n ")" ::: "memory")
#define PG8_WAIT_L(n) asm volatile("s_waitcnt lgkmcnt(" #n ")" ::: "memory")
#define PG8_BAR __builtin_amdgcn_s_barrier()
#define PG8_SCHED __builtin_amdgcn_sched_barrier(0)
    Unit cur, nxt; int ui = 0;
    if (!S.next(0, cur)) return;
    f32x4 acc[2][2][4][2];
#pragma unroll
    for (int a = 0; a < 2; ++a)
#pragma unroll
        for (int b = 0; b < 2; ++b)
#pragma unroll
            for (int m = 0; m < 4; ++m)
#pragma unroll
                for (int n = 0; n < 2; ++n) acc[a][b][m][n] = (f32x4){0.f, 0.f, 0.f, 0.f};
    bf16x8 At[4][2], B0[2][2], B1[2][2];
    const char* cA = (const char*)g.A + (size_t)cur.pm * tstep; const char* cB = (const char*)g.Bt + (size_t)cur.pn * tstep;
    S.a_ready(cur);
    if constexpr (SP2) {
        PG8_STAGE(PG8_SB(0, 0), cB, voffB); PG8_STAGE(PG8_SB(0, 1), cB + hstep, voffB); PG8_STAGE(PG8_SA(0, 0), cA, voffA); PG8_STAGE(PG8_SA(0, 1), cA + hstep, voffA);
        if (wr == 1) PG8_BAR;
        PG8_WAIT_V(2); PG8_BAR;
        PG8_STAGE(PG8_SB(1, 0), cB + kstep, voffB); PG8_STAGE(PG8_SA(1, 0), cA + kstep, voffA); PG8_STAGE(PG8_SB(1, 1), cB + hstep + kstep, voffB);
        PG8_WAIT_V(6); PG8_BAR;
    } else {
        PG8_STAGE(PG8_SB(0, 0), cB, voffB); PG8_STAGE(PG8_SA(0, 0), cA, voffA); PG8_STAGE(PG8_SB(0, 1), cB + hstep, voffB); PG8_STAGE(PG8_SA(0, 1), cA + hstep, voffA);
        if (wr == 1) PG8_BAR;
        PG8_WAIT_V(4); PG8_BAR;
        PG8_STAGE(PG8_SB(1, 0), cB + kstep, voffB); PG8_STAGE(PG8_SA(1, 0), cA + kstep, voffA); PG8_STAGE(PG8_SB(1, 1), cB + hstep + kstep, voffB);
        PG8_WAIT_V(6); PG8_BAR;
    }
    for (;;) {
        const bool has_next = S.next(ui + 1, nxt);
        const char* nA = has_next ? (const char*)g.A + (size_t)nxt.pm * tstep : cA; const char* nB = has_next ? (const char*)g.Bt + (size_t)nxt.pn * tstep : cB;
        for (int t = 0; t < nt; t += 2) {
            const bool last = (t == nt - 2);
            const char* a1 = cA + (size_t)(t + 1) * kstep;
            const char* a2 = last ? nA : cA + (size_t)(t + 2) * kstep; const char* b2 = last ? nB : cB + (size_t)(t + 2) * kstep;
            const char* a3 = a2 + kstep; const char* b3 = b2 + kstep;
            if (last && has_next) S.a_ready(nxt);
            if constexpr (SP2) {
            PG8_LDB(B0, 0, 0); PG8_LDB(B1, 0, 1); PG8_SCHED; PG8_LDA(At, 0, 0); PG8_STAGE(PG8_SA(1, 1), a1 + hstep, voffA);
            PG8_WAIT_V(8); PG8_WAIT_L(0); PG8_BAR; PG8_MMA(0, 0, At, B0); PG8_MMA(0, 1, At, B1); PG8_BAR; PG8_SCHED;
            PG8_LDA(At, 0, 1); PG8_STAGE(PG8_SB(0, 0), b2, voffB); PG8_STAGE(PG8_SB(0, 1), b2 + hstep, voffB); PG8_STAGE(PG8_SA(0, 0), a2, voffA);
            PG8_WAIT_V(8); PG8_WAIT_L(0); PG8_BAR; PG8_MMA(1, 0, At, B0); PG8_MMA(1, 1, At, B1); PG8_BAR; PG8_SCHED;
            PG8_LDB(B0, 1, 0); PG8_LDB(B1, 1, 1); PG8_SCHED; PG8_LDA(At, 1, 0); PG8_STAGE(PG8_SA(0, 1), a2 + hstep, voffA);
            PG8_WAIT_V(8); PG8_WAIT_L(0); PG8_BAR; PG8_MMA(0, 0, At, B0); PG8_MMA(0, 1, At, B1); PG8_BAR; PG8_SCHED;
            PG8_LDA(At, 1, 1); PG8_STAGE(PG8_SB(1, 0), b3, voffB); PG8_STAGE(PG8_SB(1, 1), b3 + hstep, voffB); PG8_STAGE(PG8_SA(1, 0), a3, voffA);
            PG8_WAIT_V(8); PG8_WAIT_L(0); PG8_BAR; PG8_MMA(1, 0, At, B0); PG8_MMA(1, 1, At, B1); PG8_BAR; PG8_SCHED;
            } else {
            PG8_LDB(B0, 0, 0); PG8_SCHED; PG8_LDA(At, 0, 0); PG8_STAGE(PG8_SA(1, 1), a1 + hstep, voffA);
            PG8_WAIT_L(8); PG8_BAR; PG8_WAIT_L(0); PG8_MMA(0, 0, At, B0); PG8_BAR; PG8_SCHED;
            PG8_LDB(B1, 0, 1); PG8_STAGE(PG8_SB(0, 0), b2, voffB);
            PG8_BAR; PG8_WAIT_L(0); PG8_MMA(0, 1, At, B1); PG8_BAR;
            PG8_LDA(At, 0, 1); PG8_STAGE(PG8_SA(0, 0), a2, voffA);
            PG8_BAR; PG8_WAIT_L(0); PG8_MMA(1, 0, At, B0); PG8_BAR; PG8_SCHED;
            PG8_STAGE(PG8_SB(0, 1), b2 + hstep, voffB);
            PG8_WAIT_V(6); PG8_BAR; PG8_MMA(1, 1, At, B1); PG8_BAR;
            PG8_LDB(B0, 1, 0); PG8_SCHED; PG8_LDA(At, 1, 0); PG8_STAGE(PG8_SA(0, 1), a2 + hstep, voffA);
            PG8_WAIT_L(8); PG8_BAR; PG8_WAIT_L(0); PG8_MMA(0, 0, At, B0); PG8_BAR; PG8_SCHED;
            PG8_LDB(B1, 1, 1); PG8_STAGE(PG8_SB(1, 0), b3, voffB);
            PG8_BAR; PG8_WAIT_L(0); PG8_MMA(0, 1, At, B1); PG8_BAR;
            PG8_LDA(At, 1, 1); PG8_STAGE(PG8_SA(1, 0), a3, voffA);
            PG8_BAR; PG8_WAIT_L(0); PG8_MMA(1, 0, At, B0); PG8_BAR; PG8_SCHED;
            PG8_STAGE(PG8_SB(1, 1), b3 + hstep, voffB);
            PG8_WAIT_V(6); PG8_BAR; PG8_MMA(1, 1, At, B1); PG8_BAR;
            }
        }
        if constexpr (ALIGN_EPI) { if (wr == 0) PG8_BAR; }
        if constexpr (!Epi::AFTER_DRAIN) { E(acc, cur, wr, wc, fr, fq); S.done(cur); }
        if (!has_next) break;
#pragma unroll
        for (int a = 0; a < 2; ++a)
#pragma unroll
            for (int b = 0; b < 2; ++b)
#pragma unroll
                for (int m = 0; m < 4; ++m)
#pragma unroll
                    for (int n = 0; n < 2; ++n) acc[a][b][m][n] = (f32x4){0.f, 0.f, 0.f, 0.f};
        cur = nxt; cA = nA; cB = nB; ++ui;
        if constexpr (ALIGN_EPI) { if (wr == 1) PG8_BAR; }
    }
    PG8_WAIT_V(0);
    if constexpr (!ALIGN_EPI) { if (wr == 0) PG8_BAR; }
    PG8_BAR;
    if constexpr (Epi::AFTER_DRAIN) { E.fused(acc, cur, wr, wc, fr, fq, lds, wid, lane); S.done(cur); }
#undef PG8_SA
#undef PG8_SB
#undef PG8_STAGE
#undef PG8_LDA
#undef PG8_LDB
#undef PG8_MMA
#undef PG8_WAIT_V
#undef PG8_WAIT_L
#undef PG8_BAR
#undef PG8_SCHED
}
}
constexpr int NWAVES = 8, NTHREADS = 512;
constexpr int BATCH = 8, SEQ = 4096, D = 1024, M = BATCH * SEQ, DFF = 2816, DPLE = 256;
constexpr int IN_COLS = 3848, PC = 3840  , RW0 = 2048  , LOC = 1536;
constexpr float NORM_EPS = 1e-6f, GN_EPS = 64e-5f, L2_EPS = 1e-6f;
constexpr size_t MiB = 1u << 20;
constexpr size_t WS_WGU1 = 0, WS_WD1 = 11 * MiB, WS_WGU2 = 17 * MiB, WS_WD2 = 28 * MiB, WS_WIN = 34 * MiB, WS_WOUT = 42 * MiB, WS_WPG = 44 * MiB, WS_WPP = 46 * MiB, WS_WL = 46 * MiB + 512 * 1024;
constexpr size_t WS_XN = 48 * MiB;
constexpr size_t WS_PROJ = 112 * MiB;
constexpr size_t WS_H = 112 * MiB;
constexpr size_t WS_T = 288 * MiB;
constexpr size_t WS_F = 352 * MiB;
constexpr size_t WS_LO = 352 * MiB;
constexpr size_t WS_LA = 480 * MiB;
constexpr size_t WS_BG = 496 * MiB;
constexpr size_t WS_END = 512 * MiB;
constexpr int LDS_BYTES = 147456;

#define LAS __attribute__((address_space(3)))
typedef unsigned short bf16;
typedef unsigned v4u __attribute__((ext_vector_type(4)));
typedef unsigned v2u __attribute__((ext_vector_type(2)));
typedef float f32x4 __attribute__((ext_vector_type(4)));
#define LDS_WAIT() asm volatile("s_waitcnt lgkmcnt(0)" ::: "memory")
__device__ __forceinline__ unsigned f2bf(float f) { unsigned u = __builtin_bit_cast(unsigned, f); return (u + 0x7fffu + ((u >> 16) & 1u)) >> 16; }
__device__ __forceinline__ unsigned pk2(float lo, float hi) { return f2bf(lo) | (f2bf(hi) << 16); }
__device__ __forceinline__ float bf2f(bf16 v) { return __uint_as_float((unsigned)v << 16); }
__device__ __forceinline__ float bflo(unsigned w) { return __uint_as_float(w << 16); }
__device__ __forceinline__ float bfhi(unsigned w) { return __uint_as_float(w & 0xffff0000u); }
__device__ __forceinline__ float sigm(float x) { return 1.f / (1.f + __expf(-x)); }
__device__ __forceinline__ float silu(float x) { return x * sigm(x); }
__device__ __forceinline__ float softplus(float x) { return fmaxf(x, 0.f) + log1pf(expf(-fabsf(x))); }
template <int CTRL> __device__ __forceinline__ float dpp_f(float v) { return __builtin_bit_cast(float, __builtin_amdgcn_update_dpp(0, __builtin_bit_cast(int, v), CTRL, 0xF, 0xF, true)); }
__device__ __forceinline__ float allsum4(float v) { v += dpp_f<0xB1>(v); v += dpp_f<0x4E>(v); return v; }
__device__ __forceinline__ float allsum8(float v) { v = allsum4(v); v += dpp_f<0x141>(v); return v; }
__device__ __forceinline__ float allsum16(float v) { v = allsum8(v); v += dpp_f<0x140>(v); return v; }

__device__ __forceinline__ float wave_sum(float v) {
    v = allsum16(v);
    const int iv = __builtin_bit_cast(int, v);
    const float r0 = __builtin_bit_cast(float, __builtin_amdgcn_readlane(iv, 0)), r1 = __builtin_bit_cast(float, __builtin_amdgcn_readlane(iv, 16));
    const float r2 = __builtin_bit_cast(float, __builtin_amdgcn_readlane(iv, 32)), r3 = __builtin_bit_cast(float, __builtin_amdgcn_readlane(iv, 48));
    return (r0 + r1) + (r2 + r3);
}

struct Args { const float* in[35]; float* out; unsigned char* ws; };

struct Frame {
    LAS unsigned char* lds;
    int tid, lane, wave, G;
    const float* const* in;
    float* out; unsigned char* ws;
};

__device__ __forceinline__ void transpose_item(const float* W, int ld, int K, bf16* WT, int k0, int sn0, int dr0, LAS float* scr, int lane) {
#pragma unroll 8
    for (int i = 0; i < 32; ++i) { const int kk = 2 * i + (lane >> 5); scr[kk * 33 + (lane & 31)] = W[(size_t)(k0 + kk) * ld + sn0 + (lane & 31)]; }
    LDS_WAIT(); asm volatile("" ::: "memory");
    const int c = lane & 7;
#pragma unroll
    for (int j = 0; j < 4; ++j) { const int n = (lane >> 3) + 8 * j; const LAS float* s = scr + (8 * c) * 33 + n;
        v4u o; o.x = pk2(s[0 * 33], s[1 * 33]); o.y = pk2(s[2 * 33], s[3 * 33]); o.z = pk2(s[4 * 33], s[5 * 33]); o.w = pk2(s[6 * 33], s[7 * 33]);
        *(v4u*)(WT + (size_t)(dr0 + n) * K + k0 + 8 * c) = o; }
    LDS_WAIT(); asm volatile("" ::: "memory");
}
template <int MODE> __device__ __forceinline__ void transpose_mat(Frame& F, const float* W, int K, int ld, int nblk, int sn_base, int dr_base, bf16* WT, int& it, int gw, int NGW, int& base) {
    const int nitems = (K / 64) * nblk;
    LAS float* scr = (LAS float*)(F.lds + F.wave * 16384);
    for (; it < base + nitems; it += NGW) { const int r = it - base, kb = r / nblk, nb = r % nblk, n0 = 32 * nb;
        int dr = dr_base + n0;
        if (MODE == 1) dr = 256 * (n0 >> 7) + (n0 & 127);
        if (MODE == 2) dr = 256 * (n0 >> 7) + 128 + (n0 & 127);
        transpose_item(W, ld, K, WT, 64 * kb, sn_base + n0, dr, scr, F.lane); }
    base += nitems;
}
__device__ __forceinline__ void p0_prologue(Frame& F) {
    const int gw = blockIdx.x * NWAVES + F.wave, NGW = F.G * NWAVES;
    unsigned char* ws = F.ws;
    int it = gw, base = 0;
    transpose_mat<1>(F, F.in[3], D, DFF, DFF / 32, 0, 0, (bf16*)(ws + WS_WGU1), it, gw, NGW, base);
    transpose_mat<2>(F, F.in[4], D, DFF, DFF / 32, 0, 0, (bf16*)(ws + WS_WGU1), it, gw, NGW, base);
    transpose_mat<0>(F, F.in[5], DFF, D, D / 32, 0, 0, (bf16*)(ws + WS_WD1), it, gw, NGW, base);
    transpose_mat<1>(F, F.in[27], D, DFF, DFF / 32, 0, 0, (bf16*)(ws + WS_WGU2), it, gw, NGW, base);
    transpose_mat<2>(F, F.in[28], D, DFF, DFF / 32, 0, 0, (bf16*)(ws + WS_WGU2), it, gw, NGW, base);
    transpose_mat<0>(F, F.in[29], DFF, D, D / 32, 0, 0, (bf16*)(ws + WS_WD2), it, gw, NGW, base);
    transpose_mat<0>(F, F.in[8], D, IN_COLS, 64, 0, 0, (bf16*)(ws + WS_WIN), it, gw, NGW, base);
    transpose_mat<0>(F, F.in[8], D, IN_COLS, 56, 2056, 2048, (bf16*)(ws + WS_WIN), it, gw, NGW, base);
    transpose_mat<0>(F, F.in[24], D, D, D / 32, 0, 0, (bf16*)(ws + WS_WOUT), it, gw, NGW, base);
    transpose_mat<0>(F, F.in[32], D, D, D / 32, 0, 0, (bf16*)(ws + WS_WPG), it, gw, NGW, base);
    transpose_mat<0>(F, F.in[33], DPLE, D, D / 32, 0, 0, (bf16*)(ws + WS_WPP), it, gw, NGW, base);
    { bf16* WL = (bf16*)(ws + WS_WL); const float* w2 = F.in[15]; const float* a2 = F.in[17]; const float* g2 = F.in[18];
      for (int idx = blockIdx.x * NTHREADS + F.tid; idx < LOC * 256; idx += F.G * NTHREADS) { const int n = idx >> 8, k = idx & 255; float v = 0.f;
          if (n < 512) { if (k < 64) v = w2[k * 512 + n]; }
          else if (n < 1024) { if (k >= 64 && k < 128) v = a2[(k - 64) * 512 + (n - 512)]; }
          else { if (k >= 128) v = g2[(k - 128) * 512 + (n - 1024)]; }
          WL[idx] = (bf16)f2bf(v); } }
    { const float* x = F.in[0]; const float* g = F.in[2]; bf16* XN = (bf16*)(ws + WS_XN);
      f32x4 gv[4];
#pragma unroll
      for (int j = 0; j < 4; ++j) gv[j] = ((const f32x4*)g)[F.lane + 64 * j];
      for (int m = gw; m < M; m += NGW) { const f32x4* xr = (const f32x4*)(x + (size_t)m * D) + F.lane; f32x4 v[4]; float s = 0.f;
#pragma unroll
          for (int j = 0; j < 4; ++j) { v[j] = xr[64 * j]; s += (v[j].x * v[j].x + v[j].y * v[j].y) + (v[j].z * v[j].z + v[j].w * v[j].w); }
          const float rstd = rsqrtf(wave_sum(s) * (1.f / D) + NORM_EPS);
          v2u* o8 = (v2u*)(XN + (size_t)m * D) + F.lane;
#pragma unroll
          for (int j = 0; j < 4; ++j) { const f32x4 o = v[j] * rstd * gv[j]; v2u w; w.x = pk2(o.x, o.y); w.y = pk2(o.z, o.w); o8[64 * j] = w; } } }
}

template <bool DO_XN, bool DO_BG>
__device__ __forceinline__ void row_phase(Frame& F, const float* Fm, const float* resid, float* xout, float scale, const float* gpost, const float* gpre, bf16* XN, const float* w_in, float* bg) {
    const int gw = blockIdx.x * NWAVES + F.wave, NGW = F.G * NWAVES;
    LAS float* W8 = (LAS float*)F.lds;
    if (DO_BG) { for (int idx = F.tid; idx < 8192; idx += NTHREADS) W8[idx] = w_in[(size_t)(idx >> 3) * IN_COLS + 2048 + (idx & 7)]; __syncthreads(); }
    f32x4 gp[4], gq[4];
#pragma unroll
    for (int j = 0; j < 4; ++j) { gp[j] = ((const f32x4*)gpost)[F.lane + 64 * j] * scale; if (DO_XN) gq[j] = ((const f32x4*)gpre)[F.lane + 64 * j]; }
    for (int m = gw; m < M; m += NGW) {
        const f32x4* fr = (const f32x4*)(Fm + (size_t)m * D) + F.lane; const f32x4* rr = (const f32x4*)(resid + (size_t)m * D) + F.lane;
        f32x4 v[4], r[4]; float s = 0.f;
#pragma unroll
        for (int j = 0; j < 4; ++j) { v[j] = fr[64 * j]; r[j] = rr[64 * j]; s += (v[j].x * v[j].x + v[j].y * v[j].y) + (v[j].z * v[j].z + v[j].w * v[j].w); }
        const float rstd = rsqrtf(wave_sum(s) * (1.f / D) + NORM_EPS);
        float s2 = 0.f;
        f32x4* xo = (f32x4*)(xout + (size_t)m * D) + F.lane;
#pragma unroll
        for (int j = 0; j < 4; ++j) { v[j] = r[j] + v[j] * rstd * gp[j]; xo[64 * j] = v[j]; s2 += (v[j].x * v[j].x + v[j].y * v[j].y) + (v[j].z * v[j].z + v[j].w * v[j].w); }
        if (DO_XN) {
            const float rstd2 = rsqrtf(wave_sum(s2) * (1.f / D) + NORM_EPS);
            v2u* o8 = (v2u*)(XN + (size_t)m * D) + F.lane;
#pragma unroll
            for (int j = 0; j < 4; ++j) { v[j] = v[j] * rstd2 * gq[j]; v2u w; w.x = pk2(v[j].x, v[j].y); w.y = pk2(v[j].z, v[j].w); o8[64 * j] = w; }
            if (DO_BG) {
                float a8[8];
#pragma unroll
                for (int q = 0; q < 8; ++q) a8[q] = 0.f;
#pragma unroll
                for (int j = 0; j < 4; ++j)
#pragma unroll
                    for (int e = 0; e < 4; ++e) { const int k = 4 * F.lane + 256 * j + e; const f32x4 wa = *(const LAS f32x4*)(W8 + k * 8), wb = *(const LAS f32x4*)(W8 + k * 8 + 4); const float xv = v[j][e];
                        a8[0] += xv * wa.x; a8[1] += xv * wa.y; a8[2] += xv * wa.z; a8[3] += xv * wa.w; a8[4] += xv * wb.x; a8[5] += xv * wb.y; a8[6] += xv * wb.z; a8[7] += xv * wb.w; }
#pragma unroll
                for (int q = 0; q < 8; ++q) a8[q] = wave_sum(a8[q]);
                if (F.lane == 0) { *(f32x4*)(bg + (size_t)m * 8) = (f32x4){a8[0], a8[1], a8[2], a8[3]}; *(f32x4*)(bg + (size_t)m * 8 + 4) = (f32x4){a8[4], a8[5], a8[6], a8[7]}; }
            }
        }
    }
}

__device__ __forceinline__ void lora_in_phase(Frame& F) {
    const bf16* proj = (const bf16*)(F.ws + WS_PROJ); bf16* LA = (bf16*)(F.ws + WS_LA); const float* mu = F.in[13];
    for (int idx = blockIdx.x * NTHREADS + F.tid; idx < M * 256; idx += F.G * NTHREADS) { const int m = idx >> 8, c = idx & 255, t = m & (SEQ - 1);
        const float cur = bf2f(proj[(size_t)m * PC + RW0 + 1536 + c]); const float prev = t > 0 ? bf2f(proj[(size_t)(m - 1) * PC + RW0 + 1536 + c]) : 0.f;
        const float xs = cur + (prev - cur) * mu[1536 + c];
        const float v = c < 64 ? tanhf(xs) : (c < 128 ? xs : sigm(xs));
        LA[idx] = (bf16)f2bf(v); }
}

__device__ __forceinline__ void gdn_scan_unit(Frame& F, int unit) {
    const int b = unit >> 4, h = (unit >> 2) & 3, sl = unit & 3, tid = F.tid;
    LAS float* QK = (LAS float*)F.lds;
    LAS float* V = QK + 32 * 256;
    LAS float* SC = V + 32 * 32;
    LAS float* OB = SC + 64;
    const bf16* proj = (const bf16*)(F.ws + WS_PROJ); const float* bg = (const float*)(F.ws + WS_BG); bf16* OY = (bf16*)(F.ws + WS_XN);
    const float* cw = F.in[9];
    const int col = tid >> 4, kq = tid & 15;
    float s[8];
#pragma unroll
    for (int e = 0; e < 8; ++e) s[e] = 0.f;
    const int c = tid & 255, hf = tid >> 8, pcol = c < 128 ? (h * 128 + c) : (512 + h * 128 + (c - 128));
    const float cw0 = cw[pcol], cw1 = cw[1536 + pcol], cw2 = cw[2 * 1536 + pcol], cw3 = cw[3 * 1536 + pcol];
    const int vi = tid >> 4, vd = (tid & 15) * 2, vcol = 1024 + h * 128 + sl * 32 + vd;
    float vw[4][2];
#pragma unroll
    for (int j = 0; j < 4; ++j) { vw[j][0] = cw[j * 1536 + vcol]; vw[j][1] = cw[j * 1536 + vcol + 1]; }
    const float Ah = -expf(F.in[10][h]), dtb = F.in[11][h];
    for (int blk = 0; blk < SEQ / 32; ++blk) {
        const int t0 = blk * 32; const size_t m0 = (size_t)b * SEQ + t0;
        {
            const int i0 = hf * 16; const bf16* pp = proj + (m0 + i0) * PC + pcol;
            float xm3 = 0.f, xm2 = 0.f, xm1 = 0.f;
            if (t0 + i0 > 0) { xm3 = bf2f(pp[-3 * PC]); xm2 = bf2f(pp[-2 * PC]); xm1 = bf2f(pp[-1 * PC]); }
#pragma unroll
            for (int ii = 0; ii < 16; ++ii) { const float x0 = bf2f(pp[(size_t)ii * PC]); const float y = cw0 * xm3 + cw1 * xm2 + cw2 * xm1 + cw3 * x0; QK[(i0 + ii) * 256 + c] = silu(y); xm3 = xm2; xm2 = xm1; xm1 = x0; }
        }
        {
            float a0 = 0.f, a1 = 0.f;
#pragma unroll
            for (int j = 0; j < 4; ++j) { const int t = t0 + vi - 3 + j; if (t >= 0) { const unsigned w = *(const unsigned*)(proj + ((size_t)b * SEQ + t) * PC + vcol); a0 += vw[j][0] * bflo(w); a1 += vw[j][1] * bfhi(w); } }
            V[vi * 32 + vd] = silu(a0); V[vi * 32 + vd + 1] = silu(a1);
        }
        if (tid < 32) { const float bv = bg[(m0 + tid) * 8 + h], av = bg[(m0 + tid) * 8 + 4 + h]; SC[tid * 2] = sigm(bv); SC[tid * 2 + 1] = expf(Ah * softplus(av + dtb)); }
        __syncthreads();
        {
            const int vid = tid >> 3, i = vid >> 1, which = vid & 1, sub = tid & 7; LAS f32x4* p = (LAS f32x4*)(QK + i * 256 + which * 128 + sub * 16);
            f32x4 a = p[0], b4 = p[1], c4 = p[2], d4 = p[3];
            float ss = (a.x * a.x + a.y * a.y + a.z * a.z + a.w * a.w) + (b4.x * b4.x + b4.y * b4.y + b4.z * b4.z + b4.w * b4.w) + (c4.x * c4.x + c4.y * c4.y + c4.z * c4.z + c4.w * c4.w) + (d4.x * d4.x + d4.y * d4.y + d4.z * d4.z + d4.w * d4.w);
            ss = allsum8(ss);
            const float sc = rsqrtf(ss + L2_EPS) * (which == 0 ? 0.08838834764831845f : 1.f);
            p[0] = a * sc; p[1] = b4 * sc; p[2] = c4 * sc; p[3] = d4 * sc;
        }
        __syncthreads();
#pragma unroll 4
        for (int i = 0; i < 32; ++i) {
            const f32x4 k0 = *(const LAS f32x4*)(QK + i * 256 + 128 + kq * 8), k1 = *(const LAS f32x4*)(QK + i * 256 + 128 + kq * 8 + 4);
            const f32x4 q0 = *(const LAS f32x4*)(QK + i * 256 + kq * 8), q1 = *(const LAS f32x4*)(QK + i * 256 + kq * 8 + 4);
            const float vj = V[i * 32 + col], beta = SC[2 * i], eg = SC[2 * i + 1];
            float dot = (k0.x * s[0] + k0.y * s[1] + k0.z * s[2] + k0.w * s[3]) + (k1.x * s[4] + k1.y * s[5] + k1.z * s[6] + k1.w * s[7]);
            dot = allsum16(dot);
            const float c1 = beta * (vj - eg * dot);
            s[0] = k0.x * c1 + eg * s[0]; s[1] = k0.y * c1 + eg * s[1]; s[2] = k0.z * c1 + eg * s[2]; s[3] = k0.w * c1 + eg * s[3];
            s[4] = k1.x * c1 + eg * s[4]; s[5] = k1.y * c1 + eg * s[5]; s[6] = k1.z * c1 + eg * s[6]; s[7] = k1.w * c1 + eg * s[7];
            float o = (q0.x * s[0] + q0.y * s[1] + q0.z * s[2] + q0.w * s[3]) + (q1.x * s[4] + q1.y * s[5] + q1.z * s[6] + q1.w * s[7]);
            o = allsum16(o);
            if (kq == 0) OB[i * 32 + col] = o;
        }
        __syncthreads();
        *(unsigned*)(OY + (m0 + vi) * D + h * 128 + sl * 32 + vd) = pk2(OB[vi * 32 + vd], OB[vi * 32 + vd + 1]);
    }
    __syncthreads();
}

__device__ __forceinline__ void rwkv_scan_unit(Frame& F, int unit) {
    const int b = unit >> 4, h = (unit >> 1) & 7, rh = unit & 1, tid = F.tid;
    LAS float* R = (LAS float*)F.lds;
    LAS float* W = R + 2048; LAS float* K = W + 2048; LAS float* KK = K + 2048; LAS float* BB = KK + 2048;
    LAS float* V = BB + 2048;
    LAS float* YB = V + 1024;
    const bf16* proj = (const bf16*)(F.ws + WS_PROJ); const bf16* LO = (const bf16*)(F.ws + WS_LO); bf16* OY = (bf16*)(F.ws + WS_XN);
    const float* mu = F.in[13];
    const int row = tid >> 4, kq = tid & 15;
    float s[4] = {0.f, 0.f, 0.f, 0.f};
    const int k = F.lane, ig = F.wave, cr = h * 64 + k;
    const float mu_r = mu[cr], mu_k = mu[512 + cr], mu_v = mu[1024 + cr], kkw = F.in[19][cr], kaw = F.in[20][cr], w0c = F.in[14][cr], a0c = F.in[16][cr];
    const int vi = tid >> 4, vd = (tid & 15) * 2;
    for (int blk = 0; blk < SEQ / 32; ++blk) {
        const int t0 = blk * 32; const size_t m0 = (size_t)b * SEQ + t0;
        {
            const int i0 = ig * 4; const bf16* pp = proj + (m0 + i0) * PC + RW0 + cr;
            float pr = 0.f, pk = 0.f, pv = 0.f;
            if (t0 + i0 > 0) { pr = bf2f(pp[-PC]); pk = bf2f(pp[-PC + 512]); pv = bf2f(pp[-PC + 1024]); }
#pragma unroll
            for (int ii = 0; ii < 4; ++ii) { const int i = i0 + ii; const bf16* q = pp + (size_t)ii * PC;
                const float cr_ = bf2f(q[0]), ck_ = bf2f(q[512]), cv_ = bf2f(q[1024]);
                const float xr = cr_ + (pr - cr_) * mu_r, xk = ck_ + (pk - ck_) * mu_k, xv = cv_ + (pv - cv_) * mu_v; pr = cr_; pk = ck_; pv = cv_;
                const float zw = w0c + bf2f(LO[(m0 + i) * LOC + cr]), a = sigm(a0c + bf2f(LO[(m0 + i) * LOC + 512 + cr]));
                const float ld = -expf(-softplus(-zw) - 0.5f);
                const float kv = xk * kkw; const float ss = wave_sum(kv * kv); const float kkn = kv * rsqrtf(ss + L2_EPS);
                R[i * 64 + k] = xr; W[i * 64 + k] = expf(ld); K[i * 64 + k] = xk * (1.f + (a - 1.f) * kaw); KK[i * 64 + k] = kkn; BB[i * 64 + k] = kkn * a;
                if ((k >> 5) == rh) V[i * 32 + (k & 31)] = xv; }
        }
        __syncthreads();
#pragma unroll 4
        for (int i = 0; i < 32; ++i) {
            const f32x4 kk4 = *(const LAS f32x4*)(KK + i * 64 + kq * 4), w4 = *(const LAS f32x4*)(W + i * 64 + kq * 4), b4 = *(const LAS f32x4*)(BB + i * 64 + kq * 4);
            const f32x4 k4 = *(const LAS f32x4*)(K + i * 64 + kq * 4), r4 = *(const LAS f32x4*)(R + i * 64 + kq * 4);
            const float v = V[i * 32 + row];
            float sa = -((kk4.x * s[0] + kk4.y * s[1]) + (kk4.z * s[2] + kk4.w * s[3]));
            sa = allsum16(sa);
            s[0] = s[0] * w4.x + sa * b4.x + v * k4.x; s[1] = s[1] * w4.y + sa * b4.y + v * k4.y; s[2] = s[2] * w4.z + sa * b4.z + v * k4.z; s[3] = s[3] * w4.w + sa * b4.w + v * k4.w;
            float y = (s[0] * r4.x + s[1] * r4.y) + (s[2] * r4.z + s[3] * r4.w);
            y = allsum16(y);
            if (kq == 0) YB[i * 32 + row] = y;
        }
        __syncthreads();
        *(unsigned*)(OY + (m0 + vi) * D + 512 + h * 64 + rh * 32 + vd) = pk2(YB[vi * 32 + vd], YB[vi * 32 + vd + 1]);
    }
    __syncthreads();
}

__device__ __forceinline__ void mixer_post_phase(Frame& F) {
    const int gw = blockIdx.x * NWAVES + F.wave, NGW = F.G * NWAVES, lane = F.lane;
    const bf16* proj = (const bf16*)(F.ws + WS_PROJ); const bf16* LO = (const bf16*)(F.ws + WS_LO); bf16* OY = (bf16*)(F.ws + WS_XN);
    const float* mu = F.in[13];
    const int gd = (lane & 15) * 8, gcol = (lane >> 4) * 128 + gd;
    const int rcol = (lane >> 3) * 64 + (lane & 7) * 8;
    float gnw[8], mur[8], muk[8], muv[8], ka[8], rk[8], gw8[8], gb8[8], a0v[8];
#pragma unroll
    for (int e = 0; e < 8; ++e) { gnw[e] = F.in[12][gd + e]; mur[e] = mu[rcol + e]; muk[e] = mu[512 + rcol + e]; muv[e] = mu[1024 + rcol + e]; ka[e] = F.in[20][rcol + e]; rk[e] = F.in[21][rcol + e]; gw8[e] = F.in[22][rcol + e]; gb8[e] = F.in[23][rcol + e]; a0v[e] = F.in[16][rcol + e]; }
    for (int m = gw; m < M; m += NGW) {
        const int t = m & (SEQ - 1);
        { const v4u ow = *(const v4u*)(OY + (size_t)m * D + gcol); const v4u zw = *(const v4u*)(proj + (size_t)m * PC + 1536 + gcol);
          float o[8] = {bflo(ow.x), bfhi(ow.x), bflo(ow.y), bfhi(ow.y), bflo(ow.z), bfhi(ow.z), bflo(ow.w), bfhi(ow.w)};
          float z[8] = {bflo(zw.x), bfhi(zw.x), bflo(zw.y), bfhi(zw.y), bflo(zw.z), bfhi(zw.z), bflo(zw.w), bfhi(zw.w)};
          float ss = 0.f;
#pragma unroll
          for (int e = 0; e < 8; ++e) ss += o[e] * o[e];
          ss = allsum16(ss); const float rstd = rsqrtf(ss * (1.f / 128.f) + NORM_EPS);
#pragma unroll
          for (int e = 0; e < 8; ++e) o[e] = o[e] * rstd * gnw[e] * silu(z[e]);
          v4u w; w.x = pk2(o[0], o[1]); w.y = pk2(o[2], o[3]); w.z = pk2(o[4], o[5]); w.w = pk2(o[6], o[7]);
          *(v4u*)(OY + (size_t)m * D + gcol) = w; }
        { const v4u yw = *(const v4u*)(OY + (size_t)m * D + 512 + rcol);
          const bf16* pc = proj + (size_t)m * PC + RW0 + rcol;
          const v4u rw_ = *(const v4u*)pc, kw_ = *(const v4u*)(pc + 512), vw_ = *(const v4u*)(pc + 1024);
          v4u prw = (v4u){0u, 0u, 0u, 0u}, pkw = prw, pvw = prw;
          if (t > 0) { prw = *(const v4u*)(pc - PC); pkw = *(const v4u*)(pc - PC + 512); pvw = *(const v4u*)(pc - PC + 1024); }
          const v4u aw = *(const v4u*)(LO + (size_t)m * LOC + 512 + rcol), gw_ = *(const v4u*)(LO + (size_t)m * LOC + 1024 + rcol);
          float y[8] = {bflo(yw.x), bfhi(yw.x), bflo(yw.y), bfhi(yw.y), bflo(yw.z), bfhi(yw.z), bflo(yw.w), bfhi(yw.w)};
          float rc[8] = {bflo(rw_.x), bfhi(rw_.x), bflo(rw_.y), bfhi(rw_.y), bflo(rw_.z), bfhi(rw_.z), bflo(rw_.w), bfhi(rw_.w)};
          float kc[8] = {bflo(kw_.x), bfhi(kw_.x), bflo(kw_.y), bfhi(kw_.y), bflo(kw_.z), bfhi(kw_.z), bflo(kw_.w), bfhi(kw_.w)};
          float vc[8] = {bflo(vw_.x), bfhi(vw_.x), bflo(vw_.y), bfhi(vw_.y), bflo(vw_.z), bfhi(vw_.z), bflo(vw_.w), bfhi(vw_.w)};
          float rp[8] = {bflo(prw.x), bfhi(prw.x), bflo(prw.y), bfhi(prw.y), bflo(prw.z), bfhi(prw.z), bflo(prw.w), bfhi(prw.w)};
          float kp[8] = {bflo(pkw.x), bfhi(pkw.x), bflo(pkw.y), bfhi(pkw.y), bflo(pkw.z), bfhi(pkw.z), bflo(pkw.w), bfhi(pkw.w)};
          float vp[8] = {bflo(pvw.x), bfhi(pvw.x), bflo(pvw.y), bfhi(pvw.y), bflo(pvw.z), bfhi(pvw.z), bflo(pvw.w), bfhi(pvw.w)};
          float av[8] = {bflo(aw.x), bfhi(aw.x), bflo(aw.y), bfhi(aw.y), bflo(aw.z), bfhi(aw.z), bflo(aw.w), bfhi(aw.w)};
          float gt[8] = {bflo(gw_.x), bfhi(gw_.x), bflo(gw_.y), bfhi(gw_.y), bflo(gw_.z), bfhi(gw_.z), bflo(gw_.w), bfhi(gw_.w)};
          float sm = 0.f, bon = 0.f;
#pragma unroll
          for (int e = 0; e < 8; ++e) { sm += y[e];
              const float xr = rc[e] + (rp[e] - rc[e]) * mur[e], xk = kc[e] + (kp[e] - kc[e]) * muk[e]; vc[e] = vc[e] + (vp[e] - vc[e]) * muv[e];
              const float kt = xk * (1.f + (sigm(a0v[e] + av[e]) - 1.f) * ka[e]); bon += xr * kt * rk[e]; }
          sm = allsum8(sm); bon = allsum8(bon);
          const float mean = sm * (1.f / 64.f); float sv = 0.f;
#pragma unroll
          for (int e = 0; e < 8; ++e) { y[e] -= mean; sv += y[e] * y[e]; }
          sv = allsum8(sv); const float rstd = rsqrtf(sv * (1.f / 64.f) + GN_EPS);
#pragma unroll
          for (int e = 0; e < 8; ++e) y[e] = (y[e] * rstd * gw8[e] + gb8[e] + bon * vc[e]) * gt[e];
          v4u w; w.x = pk2(y[0], y[1]); w.y = pk2(y[2], y[3]); w.z = pk2(y[4], y[5]); w.w = pk2(y[6], y[7]);
          *(v4u*)(OY + (size_t)m * D + 512 + rcol) = w; }
    }
}

__global__ void __launch_bounds__(NTHREADS, 2) mega_fwd(Args args) {
    extern __shared__ __attribute__((aligned(16))) unsigned char lds[];
    cg::grid_group grid = cg::this_grid();
    Frame F;
    F.lds = (LAS unsigned char*)lds; F.wave = __builtin_amdgcn_readfirstlane((int)threadIdx.x >> 6); F.G = gridDim.x;
#define REFRESH() do { F.lane = pg8::lane_id_opaque(); F.tid = F.wave * 64 + F.lane; } while (0)
    REFRESH();
    F.in = args.in; F.out = args.out; F.ws = args.ws;
    unsigned char* ws = args.ws;
    bf16* XN = (bf16*)(ws + WS_XN); bf16* H = (bf16*)(ws + WS_H); float* Fm = (float*)(ws + WS_F); bf16* PROJ = (bf16*)(ws + WS_PROJ); bf16* Tm = (bf16*)(ws + WS_T);
    bf16* LO = (bf16*)(ws + WS_LO); bf16* LA = (bf16*)(ws + WS_LA); float* BG = (float*)(ws + WS_BG);
    const int bx = (int)blockIdx.x;

    p0_prologue(F);
    grid.sync(); REFRESH();
    { pg8::Gemm g{XN, (const bf16*)(ws + WS_WGU1), M, 2 * DFF, D}; pg8::StaticOrder S; S.init(M, 2 * DFF, F.G, bx); pg8::EpiSwiglu E{H, DFF};
      pg8::gemm_phase<pg8::EpiSwiglu, pg8::StaticOrder, true, true>(F.lds, g, S, E, F.wave); }
    grid.sync(); REFRESH();
    { pg8::Gemm g{H, (const bf16*)(ws + WS_WD1), M, D, DFF}; pg8::StaticOrder S; S.init(M, D, F.G, bx); pg8::EpiF32 E{Fm, D};
      pg8::gemm_phase<pg8::EpiF32, pg8::StaticOrder, true, true>(F.lds, g, S, E, F.wave); }
    grid.sync(); REFRESH();
    row_phase<true, true>(F, Fm, F.in[0], F.out, 0.5f, F.in[6], F.in[7], XN, F.in[8], BG);
    grid.sync(); REFRESH();
    { pg8::Gemm g{XN, (const bf16*)(ws + WS_WIN), M, PC, D}; pg8::StaticOrder S; S.init(M, PC, F.G, bx); pg8::EpiBf16<0> E{PROJ, PC, nullptr, 0, 0, 1.f};
      pg8::gemm_phase<pg8::EpiBf16<0>, pg8::StaticOrder, true, true>(F.lds, g, S, E, F.wave); }
    grid.sync(); REFRESH();
    lora_in_phase(F);
    grid.sync(); REFRESH();
    { pg8::Gemm g{LA, (const bf16*)(ws + WS_WL), M, LOC, 256}; pg8::StaticOrder S; S.init(M, LOC, F.G, bx); pg8::EpiBf16<0> E{LO, LOC, nullptr, 0, 0, 1.f};
      pg8::gemm_phase<pg8::EpiBf16<0>, pg8::StaticOrder, true, true>(F.lds, g, S, E, F.wave); }
    grid.sync(); REFRESH();
    for (int u = bx; u < 256; u += F.G) { if (u < 128) gdn_scan_unit(F, u); else rwkv_scan_unit(F, u - 128); }
    grid.sync(); REFRESH();
    mixer_post_phase(F);
    grid.sync(); REFRESH();
    { pg8::Gemm g{XN, (const bf16*)(ws + WS_WOUT), M, D, D}; pg8::StaticOrder S; S.init(M, D, F.G, bx); pg8::EpiF32 E{Fm, D};
      pg8::gemm_phase<pg8::EpiF32, pg8::StaticOrder, true, true>(F.lds, g, S, E, F.wave); }
    grid.sync(); REFRESH();
    row_phase<true, false>(F, Fm, F.out, F.out, 1.0f, F.in[25], F.in[26], XN, nullptr, nullptr);
    { const float* p = F.in[1]; v2u* P16 = (v2u*)(ws + WS_LA);
      for (int idx = bx * NTHREADS + F.tid; idx < M * DPLE / 4; idx += F.G * NTHREADS) { const f32x4 v = ((const f32x4*)p)[idx]; v2u w; w.x = pk2(v.x, v.y); w.y = pk2(v.z, v.w); P16[idx] = w; } }
    grid.sync(); REFRESH();
    { pg8::Gemm g{XN, (const bf16*)(ws + WS_WGU2), M, 2 * DFF, D}; pg8::StaticOrder S; S.init(M, 2 * DFF, F.G, bx); pg8::EpiSwiglu E{H, DFF};
      pg8::gemm_phase<pg8::EpiSwiglu, pg8::StaticOrder, true, true>(F.lds, g, S, E, F.wave); }
    grid.sync(); REFRESH();
    { pg8::Gemm g{H, (const bf16*)(ws + WS_WD2), M, D, DFF}; pg8::StaticOrder S; S.init(M, D, F.G, bx); pg8::EpiF32 E{Fm, D};
      pg8::gemm_phase<pg8::EpiF32, pg8::StaticOrder, true, true>(F.lds, g, S, E, F.wave); }
    { pg8::Gemm g{LA, (const bf16*)(ws + WS_WPP), M, D, DPLE}; pg8::StaticOrder S; S.init(M, D, F.G, bx); pg8::EpiBf16<0> E{Tm, D, nullptr, 0, 0, 1.f};
      pg8::gemm_phase<pg8::EpiBf16<0>, pg8::StaticOrder, true, true>(F.lds, g, S, E, F.wave); }
    grid.sync(); REFRESH();
    row_phase<true, false>(F, Fm, F.out, F.out, 0.5f, F.in[30], F.in[31], XN, nullptr, nullptr);
    grid.sync(); REFRESH();
    { pg8::Gemm g{XN, (const bf16*)(ws + WS_WPG), M, D, D}; pg8::StaticOrder S; S.init(M, D, F.G, bx); pg8::EpiPle E{Fm, Tm, D};
      pg8::gemm_phase<pg8::EpiPle, pg8::StaticOrder, true, true>(F.lds, g, S, E, F.wave); }
    grid.sync(); REFRESH();
    row_phase<false, false>(F, Fm, F.out, F.out, 1.0f, F.in[34], nullptr, nullptr, nullptr, nullptr);
}

extern "C" void kernel_launch(void* const* d_in, const int* in_sizes, int n_in, void* d_out, int out_size, void* d_ws, size_t ws_size, hipStream_t stream) {
    static int grid = 0;
    if (grid == 0) {
        if (n_in != 35 || in_sizes[0] != M * D || out_size != M * D || ws_size < WS_END) { fprintf(stderr, "kernel_launch: unexpected shapes: n_in %d in0 %d out %d ws %zu; nothing launched\n", n_in, n_in > 0 ? in_sizes[0] : -1, out_size, ws_size); grid = -1; return; }
        int dev = 0, cus = 0, per_cu = 0;
        hipGetDevice(&dev); hipDeviceGetAttribute(&cus, hipDeviceAttributeMultiprocessorCount, dev);
        if (hipFuncSetAttribute((const void*)mega_fwd, hipFuncAttributeMaxDynamicSharedMemorySize, LDS_BYTES) != hipSuccess) { fprintf(stderr, "kernel_launch: hipFuncSetAttribute failed\n"); grid = -1; return; }
        if (hipOccupancyMaxActiveBlocksPerMultiprocessor(&per_cu, (const void*)mega_fwd, NTHREADS, LDS_BYTES) != hipSuccess || per_cu < 1) { fprintf(stderr, "kernel_launch: occupancy query says %d\n", per_cu); per_cu = 1; }
        (void)hipGetLastError();
        grid = cus;
    }
    if (grid < 0) return;
    Args a{};
    for (int i = 0; i < 35; ++i) a.in[i] = (const float*)d_in[i];
    a.out = (float*)d_out; a.ws = (unsigned char*)d_ws;
    void* kargs[] = {&a};
    hipError_t e = hipLaunchCooperativeKernel((const void*)mega_fwd, dim3(grid), dim3(NTHREADS), kargs, LDS_BYTES, stream);
    if (e != hipSuccess) fprintf(stderr, "kernel_launch: cooperative launch failed: %s (grid %d)\n", hipGetErrorString(e), grid);
}
```

```cpp
#include <hip/hip_runtime.h>
#include <hip/hip_cooperative_groups.h>
#include <cstdio>
#include <cstdint>
namespace cg = cooperative_groups;
namespace pg8 {
#define PG8_LAS __attribute__((address_space(3)))
typedef unsigned short bf16_t;
typedef short bf16x8 __attribute__((ext_vector_type(8)));
typedef float f32x4 __attribute__((ext_vector_type(4)));
typedef unsigned u32x4 __attribute__((ext_vector_type(4)));
constexpr int BM = 256, BK = 64, HALF = 128, HTB = HALF * BK * 2  , STAGE_BYTES = 8 * HTB, NXCD = 8, WGM = 8;

__host__ __device__ __forceinline__ int lds_byte(int r, int c) { const int st = (r >> 4) * 2 + (c >> 5), rr = r & 15, cc = c & 31, ob = rr * 64 + cc * 2; return st * 1024 + (ob ^ (((ob >> 9) & 1) << 5)); }
__host__ __device__ __forceinline__ void stage_rc(int b, int& R, int& C) { const int st = b / 1024, sb = b % 1024, swz = sb ^ (((sb >> 9) & 1) << 5); R = (st >> 1) * 16 + swz / 64; C = (st & 1) * 32 + (swz % 64) / 2; }
__host__ __device__ __forceinline__ int perm32(int rho) { const int n = rho >> 4, i = rho & 15; return 8 * (i >> 2) + 4 * n + (i & 3); }

struct Unit { int pm, pn; };
struct Gemm { const bf16_t* A; const bf16_t* Bt; int M, N, K, LD; };

struct StaticOrder {
    int nM, nN, nwg, G, c, rev;
    __host__ __device__ void init(int M, int N, int G_, int c_) { nM = M / BM; nN = N / BM; nwg = nM * nN; G = G_; c = c_; rev = 0; }
    __host__ __device__ bool next(int i, Unit& u) const {
        const long L = (long)i * G + c; if (L >= nwg) return false;
        int wgid = (int)L; { const int q = nwg / NXCD, r = nwg % NXCD, xcd = wgid % NXCD, off = wgid / NXCD; wgid = (xcd < r ? xcd * (q + 1) : r * (q + 1) + (xcd - r) * q) + off; }
        const int nig = WGM * nN, gid = wgid / nig, fm = gid * WGM, gsz = (nM - fm) < WGM ? (nM - fm) : WGM;
        u.pm = fm + ((wgid % nig) % gsz); u.pn = (wgid % nig) / gsz; if (rev) u.pm = nM - 1 - u.pm; return true;
    }
    __device__ __forceinline__ void a_ready(const Unit&) const {}
    __device__ __forceinline__ void done(const Unit&) const {}
};

__device__ __forceinline__ unsigned cvt_pk_bf16(float lo, float hi) { unsigned r; asm volatile("v_cvt_pk_bf16_f32 %0, %1, %2" : "=v"(r) : "v"(lo), "v"(hi)); return r; }
typedef float f32x2 __attribute__((ext_vector_type(2)));
__device__ __forceinline__ f32x2 gelu_pk(f32x2 v) {
    const f32x2 av = __builtin_elementwise_abs(v), d = av * 0.2316418882f + 1.0f;
    f32x2 t; t.x = __builtin_amdgcn_rcpf(d.x); t.y = __builtin_amdgcn_rcpf(d.y);
    f32x2 q = t * 0.5307027145f + (-0.7265760135f); q = q * t + 0.7107068705f; q = q * t + (-0.142248368f); q = q * t + 0.127414796f; q = q * t;
    const f32x2 s = (v * v) * (-0.72134752044f);
    f32x2 e; e.x = __builtin_amdgcn_exp2f(s.x); e.y = __builtin_amdgcn_exp2f(s.y);
    const f32x2 m = v * (q * e), r = v - m;
    f32x2 o; o.x = v.x < 0.f ? m.x : r.x; o.y = v.y < 0.f ? m.y : r.y; return o;
}

template <int ACT  > struct EpiBf16 {
    static constexpr bool PERM = true, AFTER_DRAIN = false; static_assert(ACT == 0 || ACT == 1, "EpiBf16: ACT is 0 (none) or 1 (gelu_pk)");
    bf16_t* O; int ldc; const float* bias; int split_cols; size_t split_stride; float scale0;
    __device__ __forceinline__ void operator()(const f32x4 (&acc)[2][2][4][2], const Unit& u, int wr, int wc, int fr, int fq) const {
        const int row0 = u.pm * BM + wr * 64 + fr; int colt = u.pn * BM; bf16_t* base = O;
        float sc = 1.f; if (split_cols) { const int t = colt / split_cols; base += (size_t)t * split_stride; colt -= t * split_cols; if (t == 0) sc = scale0; }
        const int col0 = colt + wc * 32 + 8 * fq, bcol0 = u.pn * BM + wc * 32 + 8 * fq;
        f32x4 bv[2][2];
#pragma unroll
        for (int bj = 0; bj < 2; ++bj)
#pragma unroll
            for (int n = 0; n < 2; ++n) bv[bj][n] = bias ? *(const f32x4*)(bias + bcol0 + bj * HALF + 4 * n) : (f32x4){0.f, 0.f, 0.f, 0.f};
#pragma unroll
        for (int ai = 0; ai < 2; ++ai)
#pragma unroll
            for (int m = 0; m < 4; ++m) { bf16_t* rowp = base + (size_t)(row0 + ai * HALF + m * 16) * ldc + col0;
#pragma unroll
                for (int bj = 0; bj < 2; ++bj) { f32x4 v0 = acc[ai][bj][m][0] + bv[bj][0], v1 = acc[ai][bj][m][1] + bv[bj][1];
                    if (ACT == 1) { f32x2 a = gelu_pk((f32x2){v0[0], v0[1]}), b = gelu_pk((f32x2){v0[2], v0[3]}), c = gelu_pk((f32x2){v1[0], v1[1]}), d = gelu_pk((f32x2){v1[2], v1[3]});
                        v0 = (f32x4){a.x, a.y, b.x, b.y}; v1 = (f32x4){c.x, c.y, d.x, d.y}; }
                    v0 = v0 * sc; v1 = v1 * sc; u32x4 w; w.x = cvt_pk_bf16(v0[0], v0[1]); w.y = cvt_pk_bf16(v0[2], v0[3]); w.z = cvt_pk_bf16(v1[0], v1[1]); w.w = cvt_pk_bf16(v1[2], v1[3]);
                    *(u32x4*)(rowp + bj * HALF) = w; } }
    }
};
__device__ __forceinline__ int lane_id_opaque() { int l; asm volatile("v_mbcnt_lo_u32_b32 %0, -1, 0\n\tv_mbcnt_hi_u32_b32 %0, -1, %0" : "=v"(l)); return l; }
__device__ __forceinline__ float sigmoid_f(float x) { return __builtin_amdgcn_rcpf(1.f + __expf(-x)); }
struct EpiF32 {
    static constexpr bool PERM = false, AFTER_DRAIN = false;
    float* C; int ldc;
    __device__ __forceinline__ void operator()(const f32x4 (&acc)[2][2][4][2], const Unit& u, int wr, int wc, int fr, int fq) const {
        const int row0 = u.pm * BM + wr * 64 + fr, col0 = u.pn * BM + wc * 32 + 4 * fq;
#pragma unroll
        for (int ai = 0; ai < 2; ++ai)
#pragma unroll
            for (int m = 0; m < 4; ++m) { float* rowp = C + (size_t)(row0 + ai * HALF + m * 16) * ldc + col0;
#pragma unroll
                for (int bj = 0; bj < 2; ++bj)
#pragma unroll
                    for (int n = 0; n < 2; ++n) *(f32x4*)(rowp + bj * HALF + n * 16) = acc[ai][bj][m][n]; }
    }
};
struct EpiSwiglu {
    static constexpr bool PERM = true, AFTER_DRAIN = false;
    bf16_t* O; int ldc;
    __device__ __forceinline__ void operator()(const f32x4 (&acc)[2][2][4][2], const Unit& u, int wr, int wc, int fr, int fq) const {
        const int row0 = u.pm * BM + wr * 64 + fr, col0 = u.pn * HALF + wc * 32 + 8 * fq;
#pragma unroll
        for (int ai = 0; ai < 2; ++ai)
#pragma unroll
            for (int m = 0; m < 4; ++m) { bf16_t* rowp = O + (size_t)(row0 + ai * HALF + m * 16) * ldc + col0;
                f32x4 h0, h1;
#pragma unroll
                for (int e = 0; e < 4; ++e) { const float g0 = acc[ai][0][m][0][e], g1 = acc[ai][0][m][1][e];
                    h0[e] = g0 * sigmoid_f(g0) * acc[ai][1][m][0][e]; h1[e] = g1 * sigmoid_f(g1) * acc[ai][1][m][1][e]; }
                u32x4 w; w.x = cvt_pk_bf16(h0[0], h0[1]); w.y = cvt_pk_bf16(h0[2], h0[3]); w.z = cvt_pk_bf16(h1[0], h1[1]); w.w = cvt_pk_bf16(h1[2], h1[3]);
                *(u32x4*)rowp = w; }
    }
};
struct EpiPle {
    static constexpr bool PERM = false, AFTER_DRAIN = false;
    bf16_t* C; const bf16_t* T; int ldc;
    __device__ __forceinline__ void operator()(const f32x4 (&acc)[2][2][4][2], const Unit& u, int wr, int wc, int fr, int fq) const {
        typedef unsigned u32x2 __attribute__((ext_vector_type(2)));
        const int row0 = u.pm * BM + wr * 64 + fr, col0 = u.pn * BM + wc * 32 + 4 * fq;
#pragma unroll
        for (int ai = 0; ai < 2; ++ai)
#pragma unroll
            for (int m = 0; m < 4; ++m) { const size_t off = (size_t)(row0 + ai * HALF + m * 16) * ldc + col0;
#pragma unroll
                for (int bj = 0; bj < 2; ++bj)
#pragma unroll
                    for (int n = 0; n < 2; ++n) { const u32x2 t = *(const u32x2*)(T + off + bj * HALF + n * 16); const f32x4 a = acc[ai][bj][m][n];
                        f32x4 o; o[0] = sigmoid_f(a[0]) * __uint_as_float(t.x << 16); o[1] = sigmoid_f(a[1]) * __uint_as_float(t.x & 0xffff0000u);
                        o[2] = sigmoid_f(a[2]) * __uint_as_float(t.y << 16); o[3] = sigmoid_f(a[3]) * __uint_as_float(t.y & 0xffff0000u);
                        u32x2 w; w.x = cvt_pk_bf16(o[0], o[1]); w.y = cvt_pk_bf16(o[2], o[3]); *(u32x2*)(C + off + bj * HALF + n * 16) = w; } }
    }
};
template <class Epi, class Sched, bool ALIGN_EPI = false, bool SP2 = false>
__device__ __forceinline__ void gemm_phase(PG8_LAS unsigned char* lds, const Gemm g, const Sched& S, const Epi& E, int wave_id) {
    int tid_ = wave_id * 64 + lane_id_opaque();
    const int tid = tid_, wid = __builtin_amdgcn_readfirstlane(tid >> 6), lane = tid & 63, wr = wid >> 2, wc = wid & 3, fr = lane & 15, fq = lane >> 4;
    const int K = g.K, nt = K / BK, LD = g.LD;
    unsigned voffA[2], voffB[2];
#pragma unroll
    for (int i = 0; i < 2; ++i) { int R, C; stage_rc(tid * 16 + i * 8192, R, C); const int Rb = Epi::PERM ? ((R & ~31) + perm32(R & 31)) : R;
        voffA[i] = (unsigned)(R * LD + C) * 2u; voffB[i] = (unsigned)(Rb * LD + C) * 2u; }
    const size_t kstep = (size_t)(BK * 2);
    const size_t hstep = (size_t)HALF * LD * 2;
    const size_t tstep = 2 * hstep;
    const unsigned ldsw = (unsigned)wid * 1024u;
    const int aoff = lds_byte(wr * 64 + fr, fq * 8), boff = lds_byte(wc * 32 + fr, fq * 8);
#define PG8_SA(b, h) (((b) * 2 + (h)) * HTB)
#define PG8_SB(b, h) ((4 + (b) * 2 + (h)) * HTB)
#define PG8_STAGE(bufoff, gbase, voff) do { _Pragma("unroll") for (int _i = 0; _i < 2; ++_i) \
        __builtin_amdgcn_global_load_lds((const unsigned*)((const char*)(gbase) + (voff)[_i]), (PG8_LAS unsigned*)(lds + (bufoff) + ldsw + _i * 8192), 16, 0, 0); } while (0)
#define PG8_LDA(dst, b, h) do { _Pragma("unroll") for (int m = 0; m < 4; ++m) _Pragma("unroll") for (int k = 0; k < 2; ++k) dst[m][k] = *(const PG8_LAS bf16x8*)(lds + PG8_SA(b, h) + aoff + m * 2048 + k * 1024); } while (0)
#define PG8_LDB(dst, b, h) do { _Pragma("unroll") for (int n = 0; n < 2; ++n) _Pragma("unroll") for (int k = 0; k < 2; ++k) dst[n][k] = *(const PG8_LAS bf16x8*)(lds + PG8_SB(b, h) + boff + n * 2048 + k * 1024); } while (0)
#define PG8_MMA(ai, bj, At, Bt) do { __builtin_amdgcn_s_setprio(1); _Pragma("unroll") for (int m = 0; m < 4; ++m) _Pragma("unroll") for (int n = 0; n < 2; ++n) _Pragma("unroll") for (int k = 0; k < 2; ++k) \
        acc[ai][bj][m][n] = __builtin_amdgcn_mfma_f32_16x16x32_bf16(Bt[n][k], At[m][k], acc[ai][bj][m][n], 0, 0, 0); __builtin_amdgcn_s_setprio(0); } while (0)
#define PG8_WAIT_V(n) asm volatile("s_waitcnt vmcnt(" #n ")" ::: "memory")
#define PG8_WAIT_L(n) asm volatile("s_waitcnt lgkmcnt(" #n ")" ::: "memory")
#define PG8_BAR __builtin_amdgcn_s_barrier()
#define PG8_SCHED __builtin_amdgcn_sched_barrier(0)
    Unit cur, nxt; int ui = 0;
    if (!S.next(0, cur)) return;
    f32x4 acc[2][2][4][2];
#pragma unroll
    for (int a = 0; a < 2; ++a)
#pragma unroll
        for (int b = 0; b < 2; ++b)
#pragma unroll
            for (int m = 0; m < 4; ++m)
#pragma unroll
                for (int n = 0; n < 2; ++n) acc[a][b][m][n] = (f32x4){0.f, 0.f, 0.f, 0.f};
    bf16x8 At[4][2], B0[2][2], B1[2][2];
    const char* cA = (const char*)g.A + (size_t)cur.pm * tstep; const char* cB = (const char*)g.Bt + (size_t)cur.pn * tstep;
    S.a_ready(cur);
    if constexpr (SP2) {
        PG8_STAGE(PG8_SB(0, 0), cB, voffB); PG8_STAGE(PG8_SB(0, 1), cB + hstep, voffB); PG8_STAGE(PG8_SA(0, 0), cA, voffA); PG8_STAGE(PG8_SA(0, 1), cA + hstep, voffA);
        if (wr == 1) PG8_BAR;
        PG8_WAIT_V(2); PG8_BAR;
        PG8_STAGE(PG8_SB(1, 0), cB + kstep, voffB); PG8_STAGE(PG8_SA(1, 0), cA + kstep, voffA); PG8_STAGE(PG8_SB(1, 1), cB + hstep + kstep, voffB);
        PG8_WAIT_V(6); PG8_BAR;
    } else {
        PG8_STAGE(PG8_SB(0, 0), cB, voffB); PG8_STAGE(PG8_SA(0, 0), cA, voffA); PG8_STAGE(PG8_SB(0, 1), cB + hstep, voffB); PG8_STAGE(PG8_SA(0, 1), cA + hstep, voffA);
        if (wr == 1) PG8_BAR;
        PG8_WAIT_V(4); PG8_BAR;
        PG8_STAGE(PG8_SB(1, 0), cB + kstep, voffB); PG8_STAGE(PG8_SA(1, 0), cA + kstep, voffA); PG8_STAGE(PG8_SB(1, 1), cB + hstep + kstep, voffB);
        PG8_WAIT_V(6); PG8_BAR;
    }
    for (;;) {
        const bool has_next = S.next(ui + 1, nxt);
        const char* nA = has_next ? (const char*)g.A + (size_t)nxt.pm * tstep : cA; const char* nB = has_next ? (const char*)g.Bt + (size_t)nxt.pn * tstep : cB;
        for (int t = 0; t < nt; t += 2) {
            const bool last = (t == nt - 2);
            const char* a1 = cA + (size_t)(t + 1) * kstep;
            const char* a2 = last ? nA : cA + (size_t)(t + 2) * kstep; const char* b2 = last ? nB : cB + (size_t)(t + 2) * kstep;
            const char* a3 = a2 + kstep; const char* b3 = b2 + kstep;
            if (last && has_next) S.a_ready(nxt);
            if constexpr (SP2) {
            PG8_LDB(B0, 0, 0); PG8_LDB(B1, 0, 1); PG8_SCHED; PG8_LDA(At, 0, 0); PG8_STAGE(PG8_SA(1, 1), a1 + hstep, voffA);
            PG8_WAIT_V(8); PG8_WAIT_L(0); PG8_BAR; PG8_MMA(0, 0, At, B0); PG8_MMA(0, 1, At, B1); PG8_BAR; PG8_SCHED;
            PG8_LDA(At, 0, 1); PG8_STAGE(PG8_SB(0, 0), b2, voffB); PG8_STAGE(PG8_SB(0, 1), b2 + hstep, voffB); PG8_STAGE(PG8_SA(0, 0), a2, voffA);
            PG8_WAIT_V(8); PG8_WAIT_L(0); PG8_BAR; PG8_MMA(1, 0, At, B0); PG8_MMA(1, 1, At, B1); PG8_BAR; PG8_SCHED;
            PG8_LDB(B0, 1, 0); PG8_LDB(B1, 1, 1); PG8_SCHED; PG8_LDA(At, 1, 0); PG8_STAGE(PG8_SA(0, 1), a2 + hstep, voffA);
            PG8_WAIT_V(8); PG8_WAIT_L(0); PG8_BAR; PG8_MMA(0, 0, At, B0); PG8_MMA(0, 1, At, B1); PG8_BAR; PG8_SCHED;
            PG8_LDA(At, 1, 1); PG8_STAGE(PG8_SB(1, 0), b3, voffB); PG8_STAGE(PG8_SB(1, 1), b3 + hstep, voffB); PG8_STAGE(PG8_SA(1, 0), a3, voffA);
            PG8_WAIT_V(8); PG8_WAIT_L(0); PG8_BAR; PG8_MMA(1, 0, At, B0); PG8_MMA(1, 1, At, B1); PG8_BAR; PG8_SCHED;
            } else {
            PG8_LDB(B0, 0, 0); PG8_SCHED; PG8_LDA(At, 0, 0); PG8_STAGE(PG8_SA(1, 1), a1 + hstep, voffA);
            PG8_WAIT_L(8); PG8_BAR; PG8_WAIT_L(0); PG8_MMA(0, 0, At, B0); PG8_BAR; PG8_SCHED;
            PG8_LDB(B1, 0, 1); PG8_STAGE(PG8_SB(0, 0), b2, voffB);
            PG8_BAR; PG8_WAIT_L(0); PG8_MMA(0, 1, At, B1); PG8_BAR;
            PG8_LDA(At, 0, 1); PG8_STAGE(PG8_SA(0, 0), a2, voffA);
            PG8_BAR; PG8_WAIT_L(0); PG8_MMA(1, 0, At, B0); PG8_BAR; PG8_SCHED;
            PG8_STAGE(PG8_SB(0, 1), b2 + hstep, voffB);
            PG8_WAIT_V(6); PG8_BAR; PG8_MMA(1, 1, At, B1); PG8_BAR;
            PG8_LDB(B0, 1, 0); PG8_SCHED; PG8_LDA(At, 1, 0); PG8_STAGE(PG8_SA(0, 1), a2 + hstep, voffA);
            PG8_WAIT_L(8); PG8_BAR; PG8_WAIT_L(0); PG8_MMA(0, 0, At, B0); PG8_BAR; PG8_SCHED;
            PG8_LDB(B1, 1, 1); PG8_STAGE(PG8_SB(1, 0), b3, voffB);
            PG8_BAR; PG8_WAIT_L(0); PG8_MMA(0, 1, At, B1); PG8_BAR;
            PG8_LDA(At, 1, 1); PG8_STAGE(PG8_SA(1, 0), a3, voffA);
            PG8_BAR; PG8_WAIT_L(0); PG8_MMA(1, 0, At, B0); PG8_BAR; PG8_SCHED;
            PG8_STAGE(PG8_SB(1, 1), b3 + hstep, voffB);
            PG8_WAIT_V(6); PG8_BAR; PG8_MMA(1, 1, At, B1); PG8_BAR;
            }
        }
        if constexpr (ALIGN_EPI) { if (wr == 0) PG8_BAR; }
        if constexpr (!Epi::AFTER_DRAIN) { E(acc, cur, wr, wc, fr, fq); S.done(cur); }
        if (!has_next) break;
#pragma unroll
        for (int a = 0; a < 2; ++a)
#pragma unroll
            for (int b = 0; b < 2; ++b)
#pragma unroll
                for (int m = 0; m < 4; ++m)
#pragma unroll
                    for (int n = 0; n < 2; ++n) acc[a][b][m][n] = (f32x4){0.f, 0.f, 0.f, 0.f};
        cur = nxt; cA = nA; cB = nB; ++ui;
        if constexpr (ALIGN_EPI) { if (wr == 1) PG8_BAR; }
    }
    PG8_WAIT_V(0);
    if constexpr (!ALIGN_EPI) { if (wr == 0) PG8_BAR; }
    PG8_BAR;
    if constexpr (Epi::AFTER_DRAIN) { E.fused(acc, cur, wr, wc, fr, fq, lds, wid, lane); S.done(cur); }
#undef PG8_SA
#undef PG8_SB
#undef PG8_STAGE
#undef PG8_LDA
#undef PG8_LDB
#undef PG8_MMA
#undef PG8_WAIT_V
#undef PG8_WAIT_L
#undef PG8_BAR
#undef PG8_SCHED
}
}
constexpr int NWAVES = 8, NTHREADS = 512;
constexpr int BATCH = 8, SEQ = 4096, D = 1024, M = BATCH * SEQ, DFF = 2816, DPLE = 256;
constexpr int HLD = 2880  , IN_COLS = 3848, PC = 3840  , RW0 = 2048  , LOC = 1536;
constexpr float NORM_EPS = 1e-6f, GN_EPS = 64e-5f, L2_EPS = 1e-6f;
constexpr size_t MiB = 1u << 20;
constexpr size_t WS_WGU1 = 0, WS_WD1 = 11 * MiB, WS_WGU2 = 17 * MiB, WS_WD2 = 28 * MiB, WS_WIN = 34 * MiB, WS_WOUT = 42 * MiB, WS_WPG = 44 * MiB, WS_WPP = 46 * MiB, WS_WL = 46 * MiB + 512 * 1024;
constexpr size_t WS_XN = 48 * MiB;
constexpr size_t WS_PROJ = 112 * MiB;
constexpr size_t WS_H = 112 * MiB;
constexpr size_t WS_T = 112 * MiB;
constexpr size_t WS_F = 352 * MiB;
constexpr size_t WS_LO = 352 * MiB;
constexpr size_t WS_LA = 480 * MiB;
constexpr size_t WS_BG = 496 * MiB;
constexpr size_t WS_XB3 = 192 * MiB;
constexpr size_t WS_BAR = 500 * MiB;
constexpr size_t WS_END = 512 * MiB;
constexpr int LDS_BYTES = 147456;

#define LAS __attribute__((address_space(3)))
typedef unsigned short bf16;
typedef unsigned v4u __attribute__((ext_vector_type(4)));
typedef unsigned v2u __attribute__((ext_vector_type(2)));
typedef float f32x4 __attribute__((ext_vector_type(4)));
#define LDS_WAIT() asm volatile("s_waitcnt lgkmcnt(0)" ::: "memory")
__device__ __forceinline__ unsigned f2bf(float f) { unsigned u = __builtin_bit_cast(unsigned, f); return (u + 0x7fffu + ((u >> 16) & 1u)) >> 16; }
__device__ __forceinline__ unsigned pk2(float lo, float hi) { return f2bf(lo) | (f2bf(hi) << 16); }
__device__ __forceinline__ float bf2f(bf16 v) { return __uint_as_float((unsigned)v << 16); }
__device__ __forceinline__ float bflo(unsigned w) { return __uint_as_float(w << 16); }
__device__ __forceinline__ float bfhi(unsigned w) { return __uint_as_float(w & 0xffff0000u); }
__device__ __forceinline__ float sigm(float x) { return 1.f / (1.f + __expf(-x)); }
__device__ __forceinline__ float silu(float x) { return x * sigm(x); }
__device__ __forceinline__ float softplus(float x) { return fmaxf(x, 0.f) + log1pf(expf(-fabsf(x))); }
template <int CTRL> __device__ __forceinline__ float dpp_f(float v) { return __builtin_bit_cast(float, __builtin_amdgcn_update_dpp(0, __builtin_bit_cast(int, v), CTRL, 0xF, 0xF, true)); }
__device__ __forceinline__ float allsum4(float v) { v += dpp_f<0xB1>(v); v += dpp_f<0x4E>(v); return v; }
__device__ __forceinline__ float allsum8(float v) { v = allsum4(v); v += dpp_f<0x141>(v); return v; }
__device__ __forceinline__ float allsum16(float v) { v = allsum8(v); v += dpp_f<0x140>(v); return v; }

__device__ __forceinline__ float wave_sum(float v) {
    v = allsum16(v);
    v += __builtin_bit_cast(float, __builtin_amdgcn_update_dpp(0, __builtin_bit_cast(int, v), 0x142, 0xA, 0xF, false));
    v += __builtin_bit_cast(float, __builtin_amdgcn_update_dpp(0, __builtin_bit_cast(int, v), 0x143, 0xC, 0xF, false));
    return __builtin_bit_cast(float, __builtin_amdgcn_readlane(__builtin_bit_cast(int, v), 63));
}

struct Args { const float* in[35]; float* out; unsigned char* ws; };

struct Frame {
    LAS unsigned char* lds;
    int tid, lane, wave, G;
    const float* const* in;
    float* out; unsigned char* ws;
};

__device__ __forceinline__ void transpose_item(const float* W, int ld, int K, bf16* WT, int k0, int sn0, int dr0, LAS float* scr, int lane, int pitch) {
    float tv[32];
#pragma unroll
    for (int i = 0; i < 32; ++i) { const int kk = 2 * i + (lane >> 5); tv[i] = W[(size_t)(k0 + kk) * ld + sn0 + (lane & 31)]; }
#pragma unroll
    for (int i = 0; i < 32; ++i) { const int kk = 2 * i + (lane >> 5); scr[kk * 33 + (lane & 31)] = tv[i]; }
    LDS_WAIT(); asm volatile("" ::: "memory");
    const int c = lane & 7;
#pragma unroll
    for (int j = 0; j < 4; ++j) { const int n = (lane >> 3) + 8 * j; const LAS float* s = scr + (8 * c) * 33 + n;
        v4u o; o.x = pk2(s[0 * 33], s[1 * 33]); o.y = pk2(s[2 * 33], s[3 * 33]); o.z = pk2(s[4 * 33], s[5 * 33]); o.w = pk2(s[6 * 33], s[7 * 33]);
        *(v4u*)(WT + (size_t)(dr0 + n) * pitch + k0 + 8 * c) = o; }
    LDS_WAIT(); asm volatile("" ::: "memory");
}
template <int MODE> __device__ __forceinline__ void transpose_mat(Frame& F, const float* W, int K, int ld, int nblk, int sn_base, int dr_base, bf16* WT, int& it, int gw, int NGW, int& base, int pitch) {
    const int nitems = (K / 64) * nblk;
    LAS float* scr = (LAS float*)(F.lds + F.wave * 16384);
    for (; it < base + nitems; it += NGW) { const int r = it - base, kb = r / nblk, nb = r % nblk, n0 = 32 * nb;
        int dr = dr_base + n0;
        if (MODE == 1) dr = 256 * (n0 >> 7) + (n0 & 127);
        if (MODE == 2) dr = 256 * (n0 >> 7) + 128 + (n0 & 127);
        transpose_item(W, ld, K, WT, 64 * kb, sn_base + n0, dr, scr, F.lane, pitch); }
    base += nitems;
}
__device__ __forceinline__ void p0_prologue(Frame& F) {
    const int gw = blockIdx.x * NWAVES + F.wave, NGW = F.G * NWAVES;
    unsigned char* ws = F.ws;
    int it = gw, base = 0;
    transpose_mat<1>(F, F.in[3], D, DFF, DFF / 32, 0, 0, (bf16*)(ws + WS_WGU1), it, gw, NGW, base, D);
    transpose_mat<2>(F, F.in[4], D, DFF, DFF / 32, 0, 0, (bf16*)(ws + WS_WGU1), it, gw, NGW, base, D);
    transpose_mat<0>(F, F.in[5], DFF, D, D / 32, 0, 0, (bf16*)(ws + WS_WD1), it, gw, NGW, base, HLD);
    transpose_mat<0>(F, F.in[8], D, IN_COLS, 64, 0, 0, (bf16*)(ws + WS_WIN), it, gw, NGW, base, D);
    transpose_mat<0>(F, F.in[8], D, IN_COLS, 56, 2056, 2048, (bf16*)(ws + WS_WIN), it, gw, NGW, base, D);
    { bf16* WL = (bf16*)(ws + WS_WL); const float* w2 = F.in[15]; const float* a2 = F.in[17]; const float* g2 = F.in[18];
      for (int idx = blockIdx.x * NTHREADS + F.tid; idx < LOC * 256; idx += F.G * NTHREADS) { const int n = idx >> 8, k = idx & 255; float v = 0.f;
          if (n < 512) { if (k < 64) v = w2[k * 512 + n]; }
          else if (n < 1024) { if (k >= 64 && k < 128) v = a2[(k - 64) * 512 + (n - 512)]; }
          else { if (k >= 128) v = g2[(k - 128) * 512 + (n - 1024)]; }
          WL[idx] = (bf16)f2bf(v); } }
    { const float* x = F.in[0]; const float* g = F.in[2]; bf16* XN = (bf16*)(ws + WS_XN);
      f32x4 gv[4];
#pragma unroll
      for (int j = 0; j < 4; ++j) gv[j] = ((const f32x4*)g)[F.lane + 64 * j];
      for (int m = gw; m < M; m += NGW) { const f32x4* xr = (const f32x4*)(x + (size_t)m * D) + F.lane; f32x4 v[4]; float s = 0.f;
#pragma unroll
          for (int j = 0; j < 4; ++j) { v[j] = __builtin_nontemporal_load(xr + 64 * j); s += (v[j].x * v[j].x + v[j].y * v[j].y) + (v[j].z * v[j].z + v[j].w * v[j].w); }
          const float rstd = rsqrtf(wave_sum(s) * (1.f / D) + NORM_EPS);
          v2u* o8 = (v2u*)(XN + (size_t)m * D) + F.lane;
#pragma unroll
          for (int j = 0; j < 4; ++j) { const f32x4 o = v[j] * rstd * gv[j]; v2u w; w.x = pk2(o.x, o.y); w.y = pk2(o.z, o.w); o8[64 * j] = w; } } }
}

__device__ __forceinline__ void late_prologue(Frame& F, int first, int count) {
    const int nb = count; if (nb <= 0 || (int)blockIdx.x < first || (int)blockIdx.x >= first + count) return;
    const int gw = ((int)blockIdx.x - first) * NWAVES + F.wave, NGW = nb * NWAVES;
    unsigned char* ws = F.ws;
    int it = gw, base = 0;
    transpose_mat<1>(F, F.in[27], D, DFF, DFF / 32, 0, 0, (bf16*)(ws + WS_WGU2), it, gw, NGW, base, D);
    transpose_mat<2>(F, F.in[28], D, DFF, DFF / 32, 0, 0, (bf16*)(ws + WS_WGU2), it, gw, NGW, base, D);
    transpose_mat<0>(F, F.in[29], DFF, D, D / 32, 0, 0, (bf16*)(ws + WS_WD2), it, gw, NGW, base, HLD);
    transpose_mat<0>(F, F.in[24], D, D, D / 32, 0, 0, (bf16*)(ws + WS_WOUT), it, gw, NGW, base, D);
    transpose_mat<0>(F, F.in[32], D, D, D / 32, 0, 0, (bf16*)(ws + WS_WPG), it, gw, NGW, base, D);
    transpose_mat<0>(F, F.in[33], DPLE, D, D / 32, 0, 0, (bf16*)(ws + WS_WPP), it, gw, NGW, base, DPLE);
    { const float* p = F.in[1]; v2u* P16 = (v2u*)(ws + WS_LA);
      for (int idx = ((int)blockIdx.x - first) * NTHREADS + F.tid; idx < M * DPLE / 4; idx += nb * NTHREADS) { const f32x4 v = ((const f32x4*)p)[idx]; v2u w; w.x = pk2(v.x, v.y); w.y = pk2(v.z, v.w); P16[idx] = w; } }
}

template <bool DO_XN, bool DO_BG, bool RIN16, bool ROUT16>
__device__ __forceinline__ void row_phase(Frame& F, const bf16* Fm, const void* resid, void* xout, float scale, const float* gpost, const float* gpre, bf16* XN, const float* w_in, float* bg) {
    const int gw = blockIdx.x * NWAVES + F.wave, NGW = F.G * NWAVES;
    LAS float* W8 = (LAS float*)F.lds;
    if (DO_BG) { for (int idx = F.tid; idx < 8192; idx += NTHREADS) W8[idx] = w_in[(size_t)(idx >> 3) * IN_COLS + 2048 + (idx & 7)]; __syncthreads(); }
    f32x4 gp[4], gq[4];
#pragma unroll
    for (int j = 0; j < 4; ++j) { gp[j] = ((const f32x4*)gpost)[F.lane + 64 * j] * scale; if (DO_XN) gq[j] = ((const f32x4*)gpre)[F.lane + 64 * j]; }
    for (int m = gw; m < M; m += NGW) {
        const v2u* fr = (const v2u*)(Fm + (size_t)m * D) + F.lane;
        f32x4 v[4], r[4]; float s = 0.f;
#pragma unroll
        for (int j = 0; j < 4; ++j) { const v2u fw = fr[64 * j]; v[j] = (f32x4){bflo(fw.x), bfhi(fw.x), bflo(fw.y), bfhi(fw.y)};
            if (RIN16) { const v2u rw = ((const v2u*)((const bf16*)resid + (size_t)m * D) + F.lane)[64 * j]; r[j] = (f32x4){bflo(rw.x), bfhi(rw.x), bflo(rw.y), bfhi(rw.y)}; }
            else r[j] = __builtin_nontemporal_load((const f32x4*)((const float*)resid + (size_t)m * D) + F.lane + 64 * j);
            s += (v[j].x * v[j].x + v[j].y * v[j].y) + (v[j].z * v[j].z + v[j].w * v[j].w); }
        const float rstd = rsqrtf(wave_sum(s) * (1.f / D) + NORM_EPS);
        float s2 = 0.f;
#pragma unroll
        for (int j = 0; j < 4; ++j) { v[j] = r[j] + v[j] * rstd * gp[j];
            if (ROUT16) { v2u w; w.x = pk2(v[j].x, v[j].y); w.y = pk2(v[j].z, v[j].w); ((v2u*)((bf16*)xout + (size_t)m * D) + F.lane)[64 * j] = w; }
            else __builtin_nontemporal_store(v[j], (f32x4*)((float*)xout + (size_t)m * D) + F.lane + 64 * j);
            s2 += (v[j].x * v[j].x + v[j].y * v[j].y) + (v[j].z * v[j].z + v[j].w * v[j].w); }
        if (DO_XN) {
            const float rstd2 = rsqrtf(wave_sum(s2) * (1.f / D) + NORM_EPS);
            v2u* o8 = (v2u*)(XN + (size_t)m * D) + F.lane;
#pragma unroll
            for (int j = 0; j < 4; ++j) { v[j] = v[j] * rstd2 * gq[j]; v2u w; w.x = pk2(v[j].x, v[j].y); w.y = pk2(v[j].z, v[j].w); o8[64 * j] = w; }
            if (DO_BG) {
                float a8[8];
#pragma unroll
                for (int q = 0; q < 8; ++q) a8[q] = 0.f;
#pragma unroll
                for (int j = 0; j < 4; ++j)
#pragma unroll
                    for (int e = 0; e < 4; ++e) { const int k = 4 * F.lane + 256 * j + e; const f32x4 wa = *(const LAS f32x4*)(W8 + k * 8), wb = *(const LAS f32x4*)(W8 + k * 8 + 4); const float xv = v[j][e];
                        a8[0] += xv * wa.x; a8[1] += xv * wa.y; a8[2] += xv * wa.z; a8[3] += xv * wa.w; a8[4] += xv * wb.x; a8[5] += xv * wb.y; a8[6] += xv * wb.z; a8[7] += xv * wb.w; }
#pragma unroll
                for (int q = 0; q < 8; ++q) a8[q] = wave_sum(a8[q]);
                if (F.lane == 0) { *(f32x4*)(bg + (size_t)m * 8) = (f32x4){a8[0], a8[1], a8[2], a8[3]}; *(f32x4*)(bg + (size_t)m * 8 + 4) = (f32x4){a8[4], a8[5], a8[6], a8[7]}; }
            }
        }
    }
}

__device__ __forceinline__ void lora_in_phase(Frame& F) {
    const bf16* proj = (const bf16*)(F.ws + WS_PROJ); bf16* LA = (bf16*)(F.ws + WS_LA); const float* mu = F.in[13];
    const int w_ = F.wave, l_ = F.lane;
    const int cp = w_ < 4 ? (w_ >> 1) * 32 + (l_ & 31) : 64 + l_, tq = w_ < 4 ? (w_ & 1) * 2 + (l_ >> 5) : w_ - 4, c = 2 * cp;
    const float mu0 = mu[1536 + c], mu1 = mu[1536 + c + 1];
    for (int tile = blockIdx.x; tile < M / 64; tile += F.G) {
        const size_t mrow = (size_t)tile * 64 + tq * 16; const int t = (int)(mrow & (SEQ - 1));
        const bf16* pp = proj + mrow * PC + RW0 + 1536 + c;
        unsigned w[17];
        w[0] = t > 0 ? *(const unsigned*)(pp - PC) : 0u;
#pragma unroll
        for (int ii = 0; ii < 16; ++ii) w[ii + 1] = *(const unsigned*)(pp + (size_t)ii * PC);
#pragma unroll
        for (int ii = 0; ii < 16; ++ii) { const float c0 = bflo(w[ii + 1]), c1 = bfhi(w[ii + 1]), p0 = bflo(w[ii]), p1 = bfhi(w[ii]);
            const float x0 = c0 + (p0 - c0) * mu0, x1 = c1 + (p1 - c1) * mu1;
            float v0, v1;
            if (w_ < 2) { v0 = tanhf(x0); v1 = tanhf(x1); } else if (w_ < 4) { v0 = x0; v1 = x1; } else { v0 = sigm(x0); v1 = sigm(x1); }
            *(unsigned*)(LA + (mrow + ii) * 256 + c) = pk2(v0, v1); }
    }
}

__device__ __forceinline__ void gdn_scan_unit(Frame& F, int unit) {
    const int b = unit >> 4, h = (unit >> 2) & 3, sl = unit & 3, tid = F.tid;
    LAS float* QK = (LAS float*)F.lds;
    LAS float* V = QK + 32 * 256;
    LAS float* SC = V + 32 * 32;
    LAS float* OB = SC + 64;
    const bf16* proj = (const bf16*)(F.ws + WS_PROJ); const float* bg = (const float*)(F.ws + WS_BG); bf16* OY = (bf16*)(F.ws + WS_XN);
    const float* cw = F.in[9];
    const int col = tid >> 4, kq = tid & 15;
    float s[8];
#pragma unroll
    for (int e = 0; e < 8; ++e) s[e] = 0.f;
    const int c = tid & 255, hf = tid >> 8, pcol = c < 128 ? (h * 128 + c) : (512 + h * 128 + (c - 128));
    const float cw0 = cw[pcol], cw1 = cw[1536 + pcol], cw2 = cw[2 * 1536 + pcol], cw3 = cw[3 * 1536 + pcol];
    const int vi = tid >> 4, vd = (tid & 15) * 2, vcol = 1024 + h * 128 + sl * 32 + vd;
    float vw[4][2];
#pragma unroll
    for (int j = 0; j < 4; ++j) { vw[j][0] = cw[j * 1536 + vcol]; vw[j][1] = cw[j * 1536 + vcol + 1]; }
    const float Ah = -expf(F.in[10][h]), dtb = F.in[11][h];
    for (int blk = 0; blk < SEQ / 32; ++blk) {
        const int t0 = blk * 32; const size_t m0 = (size_t)b * SEQ + t0;
        {
            const int i0 = hf * 16; const bf16* pp = proj + (m0 + i0) * PC + pcol;
            float xm3 = 0.f, xm2 = 0.f, xm1 = 0.f;
            if (t0 + i0 > 0) { xm3 = bf2f(pp[-3 * PC]); xm2 = bf2f(pp[-2 * PC]); xm1 = bf2f(pp[-1 * PC]); }
#pragma unroll
            for (int ii = 0; ii < 16; ++ii) { const float x0 = bf2f(pp[(size_t)ii * PC]); const float y = cw0 * xm3 + cw1 * xm2 + cw2 * xm1 + cw3 * x0; QK[(i0 + ii) * 256 + c] = silu(y); xm3 = xm2; xm2 = xm1; xm1 = x0; }
        }
        {
            float a0 = 0.f, a1 = 0.f;
#pragma unroll
            for (int j = 0; j < 4; ++j) { const int t = t0 + vi - 3 + j; if (t >= 0) { const unsigned w = *(const unsigned*)(proj + ((size_t)b * SEQ + t) * PC + vcol); a0 += vw[j][0] * bflo(w); a1 += vw[j][1] * bfhi(w); } }
            V[vi * 32 + vd] = silu(a0); V[vi * 32 + vd + 1] = silu(a1);
        }
        if (tid < 32) { const float bv = bg[(m0 + tid) * 8 + h], av = bg[(m0 + tid) * 8 + 4 + h]; SC[tid * 2] = sigm(bv); SC[tid * 2 + 1] = expf(Ah * softplus(av + dtb)); }
        __syncthreads();
        {
            const int vid = tid >> 3, i = vid >> 1, which = vid & 1, sub = tid & 7; LAS f32x4* p = (LAS f32x4*)(QK + i * 256 + which * 128 + sub * 16);
            f32x4 a = p[0], b4 = p[1], c4 = p[2], d4 = p[3];
            float ss = (a.x * a.x + a.y * a.y + a.z * a.z + a.w * a.w) + (b4.x * b4.x + b4.y * b4.y + b4.z * b4.z + b4.w * b4.w) + (c4.x * c4.x + c4.y * c4.y + c4.z * c4.z + c4.w * c4.w) + (d4.x * d4.x + d4.y * d4.y + d4.z * d4.z + d4.w * d4.w);
            ss = allsum8(ss);
            const float sc = rsqrtf(ss + L2_EPS) * (which == 0 ? 0.08838834764831845f : 1.f);
            p[0] = a * sc; p[1] = b4 * sc; p[2] = c4 * sc; p[3] = d4 * sc;
        }
        __syncthreads();
#pragma unroll 4
        for (int i = 0; i < 32; ++i) {
            const f32x4 k0 = *(const LAS f32x4*)(QK + i * 256 + 128 + kq * 8), k1 = *(const LAS f32x4*)(QK + i * 256 + 128 + kq * 8 + 4);
            const f32x4 q0 = *(const LAS f32x4*)(QK + i * 256 + kq * 8), q1 = *(const LAS f32x4*)(QK + i * 256 + kq * 8 + 4);
            const float vj = V[i * 32 + col], beta = SC[2 * i], eg = SC[2 * i + 1];
            float dot = (k0.x * s[0] + k0.y * s[1] + k0.z * s[2] + k0.w * s[3]) + (k1.x * s[4] + k1.y * s[5] + k1.z * s[6] + k1.w * s[7]);
            dot = allsum16(dot);
            const float c1 = beta * (vj - eg * dot);
            s[0] = k0.x * c1 + eg * s[0]; s[1] = k0.y * c1 + eg * s[1]; s[2] = k0.z * c1 + eg * s[2]; s[3] = k0.w * c1 + eg * s[3];
            s[4] = k1.x * c1 + eg * s[4]; s[5] = k1.y * c1 + eg * s[5]; s[6] = k1.z * c1 + eg * s[6]; s[7] = k1.w * c1 + eg * s[7];
            float o = (q0.x * s[0] + q0.y * s[1] + q0.z * s[2] + q0.w * s[3]) + (q1.x * s[4] + q1.y * s[5] + q1.z * s[6] + q1.w * s[7]);
            o = allsum16(o);
            if (kq == 0) OB[i * 32 + col] = o;
        }
        __syncthreads();
        *(unsigned*)(OY + (m0 + vi) * D + h * 128 + sl * 32 + vd) = pk2(OB[vi * 32 + vd], OB[vi * 32 + vd + 1]);
    }
    __syncthreads();
}

__device__ __forceinline__ void rwkv_scan_unit(Frame& F, int unit) {
    const int b = unit >> 4, h = (unit >> 1) & 7, rh = unit & 1, tid = F.tid;
    LAS float* R = (LAS float*)F.lds;
    LAS float* W = R + 2048; LAS float* K = W + 2048; LAS float* KK = K + 2048; LAS float* BB = KK + 2048;
    LAS float* V = BB + 2048;
    LAS float* YB = V + 1024;
    const bf16* proj = (const bf16*)(F.ws + WS_PROJ); const bf16* LO = (const bf16*)(F.ws + WS_LO); bf16* OY = (bf16*)(F.ws + WS_XN);
    const float* mu = F.in[13];
    const int row = tid >> 4, kq = tid & 15;
    float s[4] = {0.f, 0.f, 0.f, 0.f};
    const int k = F.lane, ig = F.wave, cr = h * 64 + k;
    const float mu_r = mu[cr], mu_k = mu[512 + cr], mu_v = mu[1024 + cr], kkw = F.in[19][cr], kaw = F.in[20][cr], w0c = F.in[14][cr], a0c = F.in[16][cr];
    const int vi = tid >> 4, vd = (tid & 15) * 2;
    for (int blk = 0; blk < SEQ / 32; ++blk) {
        const int t0 = blk * 32; const size_t m0 = (size_t)b * SEQ + t0;
        {
            const int i0 = ig * 4; const bf16* pp = proj + (m0 + i0) * PC + RW0 + cr;
            float pr = 0.f, pk = 0.f, pv = 0.f;
            if (t0 + i0 > 0) { pr = bf2f(pp[-PC]); pk = bf2f(pp[-PC + 512]); pv = bf2f(pp[-PC + 1024]); }
#pragma unroll
            for (int ii = 0; ii < 4; ++ii) { const int i = i0 + ii; const bf16* q = pp + (size_t)ii * PC;
                const float cr_ = bf2f(q[0]), ck_ = bf2f(q[512]), cv_ = bf2f(q[1024]);
                const float xr = cr_ + (pr - cr_) * mu_r, xk = ck_ + (pk - ck_) * mu_k, xv = cv_ + (pv - cv_) * mu_v; pr = cr_; pk = ck_; pv = cv_;
                const float zw = w0c + bf2f(LO[(m0 + i) * LOC + cr]), a = sigm(a0c + bf2f(LO[(m0 + i) * LOC + 512 + cr]));
                const float ld = -expf(-softplus(-zw) - 0.5f);
                const float kv = xk * kkw; const float ss = wave_sum(kv * kv); const float kkn = kv * rsqrtf(ss + L2_EPS);
                R[i * 64 + k] = xr; W[i * 64 + k] = expf(ld); K[i * 64 + k] = xk * (1.f + (a - 1.f) * kaw); KK[i * 64 + k] = kkn; BB[i * 64 + k] = kkn * a;
                if ((k >> 5) == rh) V[i * 32 + (k & 31)] = xv; }
        }
        __syncthreads();
#pragma unroll 4
        for (int i = 0; i < 32; ++i) {
            const f32x4 kk4 = *(const LAS f32x4*)(KK + i * 64 + kq * 4), w4 = *(const LAS f32x4*)(W + i * 64 + kq * 4), b4 = *(const LAS f32x4*)(BB + i * 64 + kq * 4);
            const f32x4 k4 = *(const LAS f32x4*)(K + i * 64 + kq * 4), r4 = *(const LAS f32x4*)(R + i * 64 + kq * 4);
            const float v = V[i * 32 + row];
            float sa = -((kk4.x * s[0] + kk4.y * s[1]) + (kk4.z * s[2] + kk4.w * s[3]));
            sa = allsum16(sa);
            s[0] = s[0] * w4.x + sa * b4.x + v * k4.x; s[1] = s[1] * w4.y + sa * b4.y + v * k4.y; s[2] = s[2] * w4.z + sa * b4.z + v * k4.z; s[3] = s[3] * w4.w + sa * b4.w + v * k4.w;
            float y = (s[0] * r4.x + s[1] * r4.y) + (s[2] * r4.z + s[3] * r4.w);
            y = allsum16(y);
            if (kq == 0) YB[i * 32 + row] = y;
        }
        __syncthreads();
        *(unsigned*)(OY + (m0 + vi) * D + 512 + h * 64 + rh * 32 + vd) = pk2(YB[vi * 32 + vd], YB[vi * 32 + vd + 1]);
    }
    __syncthreads();
}

__device__ __forceinline__ void mixer_post_phase(Frame& F) {
    const int gw = blockIdx.x * NWAVES + F.wave, NGW = F.G * NWAVES, lane = F.lane;
    const bf16* proj = (const bf16*)(F.ws + WS_PROJ); const bf16* LO = (const bf16*)(F.ws + WS_LO); bf16* OY = (bf16*)(F.ws + WS_XN);
    const float* mu = F.in[13];
    const int gd = (lane & 15) * 8, gcol = (lane >> 4) * 128 + gd;
    const int rcol = (lane >> 3) * 64 + (lane & 7) * 8;
    float gnw[8], mur[8], muk[8], muv[8], ka[8], rk[8], gw8[8], gb8[8], a0v[8];
#pragma unroll
    for (int e = 0; e < 8; ++e) { gnw[e] = F.in[12][gd + e]; mur[e] = mu[rcol + e]; muk[e] = mu[512 + rcol + e]; muv[e] = mu[1024 + rcol + e]; ka[e] = F.in[20][rcol + e]; rk[e] = F.in[21][rcol + e]; gw8[e] = F.in[22][rcol + e]; gb8[e] = F.in[23][rcol + e]; a0v[e] = F.in[16][rcol + e]; }
    for (int m = gw; m < M; m += NGW) {
        const int t = m & (SEQ - 1);
        { const v4u ow = *(const v4u*)(OY + (size_t)m * D + gcol); const v4u zw = *(const v4u*)(proj + (size_t)m * PC + 1536 + gcol);
          float o[8] = {bflo(ow.x), bfhi(ow.x), bflo(ow.y), bfhi(ow.y), bflo(ow.z), bfhi(ow.z), bflo(ow.w), bfhi(ow.w)};
          float z[8] = {bflo(zw.x), bfhi(zw.x), bflo(zw.y), bfhi(zw.y), bflo(zw.z), bfhi(zw.z), bflo(zw.w), bfhi(zw.w)};
          float ss = 0.f;
#pragma unroll
          for (int e = 0; e < 8; ++e) ss += o[e] * o[e];
          ss = allsum16(ss); const float rstd = rsqrtf(ss * (1.f / 128.f) + NORM_EPS);
#pragma unroll
          for (int e = 0; e < 8; ++e) o[e] = o[e] * rstd * gnw[e] * silu(z[e]);
          v4u w; w.x = pk2(o[0], o[1]); w.y = pk2(o[2], o[3]); w.z = pk2(o[4], o[5]); w.w = pk2(o[6], o[7]);
          *(v4u*)(OY + (size_t)m * D + gcol) = w; }
        { const v4u yw = *(const v4u*)(OY + (size_t)m * D + 512 + rcol);
          const bf16* pc = proj + (size_t)m * PC + RW0 + rcol;
          const v4u rw_ = *(const v4u*)pc, kw_ = *(const v4u*)(pc + 512), vw_ = *(const v4u*)(pc + 1024);
          v4u prw = (v4u){0u, 0u, 0u, 0u}, pkw = prw, pvw = prw;
          if (t > 0) { prw = *(const v4u*)(pc - PC); pkw = *(const v4u*)(pc - PC + 512); pvw = *(const v4u*)(pc - PC + 1024); }
          const v4u aw = *(const v4u*)(LO + (size_t)m * LOC + 512 + rcol), gw_ = *(const v4u*)(LO + (size_t)m * LOC + 1024 + rcol);
          float y[8] = {bflo(yw.x), bfhi(yw.x), bflo(yw.y), bfhi(yw.y), bflo(yw.z), bfhi(yw.z), bflo(yw.w), bfhi(yw.w)};
          float rc[8] = {bflo(rw_.x), bfhi(rw_.x), bflo(rw_.y), bfhi(rw_.y), bflo(rw_.z), bfhi(rw_.z), bflo(rw_.w), bfhi(rw_.w)};
          float kc[8] = {bflo(kw_.x), bfhi(kw_.x), bflo(kw_.y), bfhi(kw_.y), bflo(kw_.z), bfhi(kw_.z), bflo(kw_.w), bfhi(kw_.w)};
          float vc[8] = {bflo(vw_.x), bfhi(vw_.x), bflo(vw_.y), bfhi(vw_.y), bflo(vw_.z), bfhi(vw_.z), bflo(vw_.w), bfhi(vw_.w)};
          float rp[8] = {bflo(prw.x), bfhi(prw.x), bflo(prw.y), bfhi(prw.y), bflo(prw.z), bfhi(prw.z), bflo(prw.w), bfhi(prw.w)};
          float kp[8] = {bflo(pkw.x), bfhi(pkw.x), bflo(pkw.y), bfhi(pkw.y), bflo(pkw.z), bfhi(pkw.z), bflo(pkw.w), bfhi(pkw.w)};
          float vp[8] = {bflo(pvw.x), bfhi(pvw.x), bflo(pvw.y), bfhi(pvw.y), bflo(pvw.z), bfhi(pvw.z), bflo(pvw.w), bfhi(pvw.w)};
          float av[8] = {bflo(aw.x), bfhi(aw.x), bflo(aw.y), bfhi(aw.y), bflo(aw.z), bfhi(aw.z), bflo(aw.w), bfhi(aw.w)};
          float gt[8] = {bflo(gw_.x), bfhi(gw_.x), bflo(gw_.y), bfhi(gw_.y), bflo(gw_.z), bfhi(gw_.z), bflo(gw_.w), bfhi(gw_.w)};
          float sm = 0.f, bon = 0.f;
#pragma unroll
          for (int e = 0; e < 8; ++e) { sm += y[e];
              const float xr = rc[e] + (rp[e] - rc[e]) * mur[e], xk = kc[e] + (kp[e] - kc[e]) * muk[e]; vc[e] = vc[e] + (vp[e] - vc[e]) * muv[e];
              const float kt = xk * (1.f + (sigm(a0v[e] + av[e]) - 1.f) * ka[e]); bon += xr * kt * rk[e]; }
          sm = allsum8(sm); bon = allsum8(bon);
          const float mean = sm * (1.f / 64.f); float sv = 0.f;
#pragma unroll
          for (int e = 0; e < 8; ++e) { y[e] -= mean; sv += y[e] * y[e]; }
          sv = allsum8(sv); const float rstd = rsqrtf(sv * (1.f / 64.f) + GN_EPS);
#pragma unroll
          for (int e = 0; e < 8; ++e) y[e] = (y[e] * rstd * gw8[e] + gb8[e] + bon * vc[e]) * gt[e];
          v4u w; w.x = pk2(y[0], y[1]); w.y = pk2(y[2], y[3]); w.z = pk2(y[4], y[5]); w.w = pk2(y[6], y[7]);
          *(v4u*)(OY + (size_t)m * D + 512 + rcol) = w; }
    }
}

#define LBAR() do { asm volatile("s_waitcnt lgkmcnt(0)" ::: "memory"); __builtin_amdgcn_s_barrier(); asm volatile("" ::: "memory"); } while (0)
typedef short bf16x8 __attribute__((ext_vector_type(8)));
typedef float f32x2_t __attribute__((ext_vector_type(2)));
typedef __bf16 bf16x2_t __attribute__((ext_vector_type(2)));
__device__ __forceinline__ unsigned cvtpk(float lo, float hi) { const f32x2_t v = {lo, hi}; const bf16x2_t b = __builtin_convertvector(v, bf16x2_t); return __builtin_bit_cast(unsigned, b); }
__device__ __forceinline__ bf16 bf1(float x) { return (bf16)cvtpk(x, 0.f); }
__device__ __forceinline__ float sigm_f(float x) { return __builtin_amdgcn_rcpf(1.f + __expf(-x)); }
__device__ __forceinline__ float silu_f(float x) { return x * sigm_f(x); }
__device__ __forceinline__ float softplus_f(float x) { return fmaxf(x, 0.f) + __logf(1.f + __expf(-fabsf(x))); }

template <bool SWAP, int K> __device__ __forceinline__ f32x4 mm_tile(const LAS bf16* X, int ldx, const LAS bf16* Y, int ldy, int ti, int tj, f32x4 acc, int r, int q) {
    const LAS bf16* xp = X + (16 * ti + r) * ldx + 8 * q; const LAS bf16* yp = Y + (16 * tj + r) * ldy + 8 * q;
#pragma unroll
    for (int k0 = 0; k0 < K; k0 += 32) { const bf16x8 xa = *(const LAS bf16x8*)(xp + k0), yb = *(const LAS bf16x8*)(yp + k0);
        acc = SWAP ? __builtin_amdgcn_mfma_f32_16x16x32_bf16(yb, xa, acc, 0, 0, 0) : __builtin_amdgcn_mfma_f32_16x16x32_bf16(xa, yb, acc, 0, 0, 0); }
    __builtin_amdgcn_sched_barrier(0);
    return acc;
}
__device__ __forceinline__ v2u pk4(f32x4 v) { v2u w; w.x = cvtpk(v[0], v[1]); w.y = cvtpk(v[2], v[3]); return w; }
__device__ __forceinline__ void lt_tile(int lt, int& ti, int& tj) {
    ti = lt < 1 ? 0 : (lt < 3 ? 1 : (lt < 6 ? 2 : 3)); tj = lt - (ti * (ti + 1)) / 2; }
__device__ __forceinline__ void tri_solve(const LAS float* Ap, LAS bf16* Tb, int wave) {
    const int st = wave * 64 + pg8::lane_id_opaque();
    const int s = st & 3, n = st >> 2;
    float tq[16];
#pragma unroll
    for (int jj = 0; jj < 16; ++jj) tq[jj] = 0.f;
    const LAS float* ap = Ap + s * 16;
    const LAS float* apu = Ap; asm volatile("" : "+v"(apu));
    f32x4 a[4][4], an[4][2]; float cc[6], cn[6];
#pragma unroll
    for (int e = 0; e < 4; ++e)
#pragma unroll
        for (int v = 0; v < 4; ++v) { a[e][v] = (f32x4){0.f, 0.f, 0.f, 0.f}; if (v < 2) an[e][v] = a[e][v]; }
    const float f0 = s == 0 ? 1.f : 0.f, f1 = s == 1 ? 1.f : 0.f, f2 = s == 2 ? 1.f : 0.f, f3 = s == 3 ? 1.f : 0.f;
#define TS_LOADC(dst, bb) do { dst[0] = apu[(4 * (bb) + 1) * 68 + (bb)]; dst[1] = apu[(4 * (bb) + 2) * 68 + (bb)]; dst[2] = apu[(4 * (bb) + 2) * 68 + 16 + (bb)]; \
        dst[3] = apu[(4 * (bb) + 3) * 68 + (bb)]; dst[4] = apu[(4 * (bb) + 3) * 68 + 16 + (bb)]; dst[5] = apu[(4 * (bb) + 3) * 68 + 32 + (bb)]; } while (0)
    TS_LOADC(cc, 0);
#pragma unroll
    for (int b = 0; b < 16; ++b) {
#pragma unroll
        for (int e = 0; e < 4; ++e)
#pragma unroll
            for (int v = 2; v < 4; ++v) if (4 * v < b) a[e][v] = *(const LAS f32x4*)(ap + (4 * b + e) * 68 + 4 * v);
        if (b + 1 < 16) {
#pragma unroll
            for (int e = 0; e < 4; ++e)
#pragma unroll
                for (int v = 0; v < 2; ++v) if (4 * v < b + 1) an[e][v] = *(const LAS f32x4*)(ap + (4 * (b + 1) + e) * 68 + 4 * v);
            TS_LOADC(cn, b + 1);
        }
        float p[4] = {0.f, 0.f, 0.f, 0.f};
#pragma unroll
        for (int jj = 0; jj < 16; ++jj) if (jj < b) {
#pragma unroll
            for (int e = 0; e < 4; ++e) p[e] += a[e][jj >> 2][jj & 3] * tq[jj]; }
#pragma unroll
        for (int e = 0; e < 4; ++e) p[e] = allsum4(p[e]);
        const float t0 = p[0] + (n == 4 * b ? 1.f : 0.f);
        const float t1 = p[1] + cc[0] * t0 + (n == 4 * b + 1 ? 1.f : 0.f);
        const float t2 = p[2] + cc[1] * t0 + cc[2] * t1 + (n == 4 * b + 2 ? 1.f : 0.f);
        const float t3 = p[3] + cc[3] * t0 + cc[4] * t1 + cc[5] * t2 + (n == 4 * b + 3 ? 1.f : 0.f);
        tq[b] = (f0 * t0 + f1 * t1) + (f2 * t2 + f3 * t3);
        asm volatile("" ::: "memory");
#pragma unroll
        for (int e = 0; e < 4; ++e)
#pragma unroll
            for (int v = 0; v < 2; ++v) a[e][v] = an[e][v];
#pragma unroll
        for (int k = 0; k < 6; ++k) cc[k] = cn[k];
    }
#undef TS_LOADC
#pragma unroll
    for (int jj = 0; jj < 16; ++jj) Tb[(4 * jj + s) * 72 + n] = bf1(tq[jj]);
}

__device__ __forceinline__ void rwkv_chunk_unit(Frame& F, int unit) {
    const int b = unit >> 4, h = (unit >> 1) & 7, hf = unit & 1, tid = F.tid, lane = F.lane, wave = F.wave;
    LAS bf16* AT = (LAS bf16*)F.lds; LAS bf16* BT = AT + 4608; LAS bf16* KT = BT + 4608; LAS bf16* QT = KT + 4608;
    LAS bf16* BDt = QT + 4608; LAS bf16* KDt = BDt + 4608; LAS bf16* Vt = KDt + 4608;
    LAS bf16* Aak = Vt + 4608; LAS bf16* Aqb = Aak + 4608; LAS bf16* Aqk = Aqb + 4608; LAS bf16* Tb = Aqk + 4608; LAS bf16* Ht = Tb + 4608;
    LAS float* Ap = (LAS float*)(Ht + 4608); LAS float* GT = Ap + 64 * 68; LAS float* GL = GT + 512;
    LAS bf16* Rt = BT; LAS bf16* Ut = AT;
    const bf16* proj = (const bf16*)(F.ws + WS_PROJ); const bf16* LO = (const bf16*)(F.ws + WS_LO); bf16* OY = (bf16*)(F.ws + WS_XN);
    const float* mu = F.in[13];
    const int c = lane, ig = wave, cr = h * 64 + c;
    const float mu_r = mu[cr], mu_k = mu[512 + cr], mu_v = mu[1024 + cr], kkw = F.in[19][cr], kaw = F.in[20][cr], w0c = F.in[14][cr], a0c = F.in[16][cr];
    for (int i = tid; i < 4608 / 2; i += NTHREADS) { ((LAS unsigned*)Ht)[i] = 0u; ((LAS unsigned*)Aak)[i] = 0u; ((LAS unsigned*)Aqb)[i] = 0u; ((LAS unsigned*)Aqk)[i] = 0u; }
    f32x4 hacc[2], yacc[2];
#pragma unroll
    for (int u = 0; u < 2; ++u) hacc[u] = (f32x4){0.f, 0.f, 0.f, 0.f};
    bf16 rr[9], rk[9], rv[9], lw[8], la[8];
#define RWKV_LOAD(chn) do { const size_t mq = (size_t)b * SEQ + (chn) * 64 + ig * 8; const bf16* pq = proj + (mq - 1) * PC + RW0 + cr; const bf16* pl = LO + mq * LOC + cr;     \
        _Pragma("unroll") for (int ii = 0; ii < 9; ++ii) { rr[ii] = pq[0]; rk[ii] = pq[512]; rv[ii] = pq[1024]; pq += PC; asm volatile("" : "+v"(pq)); } \
        _Pragma("unroll") for (int ii = 0; ii < 8; ++ii) { lw[ii] = pl[0]; la[ii] = pl[512]; pl += LOC; asm volatile("" : "+v"(pl)); } } while (0)
    __syncthreads();
    for (int ch = 0; ch < SEQ / 64; ++ch) {
        const int t0 = ch * 64; const size_t m0 = (size_t)b * SEQ + t0;
        const int lq = pg8::lane_id_opaque(), r = lq & 15, q = lq >> 4;
        float xr[8], kt[8], xv[8], kkn[8], bb[8], ldv[8], lc[8];
        RWKV_LOAD(ch);
        {
            float run = 0.f;
#pragma unroll
            for (int ii = 0; ii < 8; ++ii) {
                const float r1 = bf2f(rr[ii + 1]), k1 = bf2f(rk[ii + 1]), v1 = bf2f(rv[ii + 1]);
                const bool z0 = (ii == 0 && t0 + ig * 8 == 0);
                xr[ii] = r1 + ((z0 ? 0.f : bf2f(rr[ii])) - r1) * mu_r; const float xk = k1 + ((z0 ? 0.f : bf2f(rk[ii])) - k1) * mu_k; xv[ii] = v1 + ((z0 ? 0.f : bf2f(rv[ii])) - v1) * mu_v;
                const float zw = w0c + bf2f(lw[ii]), a = sigm_f(a0c + bf2f(la[ii]));
                ldv[ii] = -__expf(-softplus_f(-zw) - 0.5f);
                const float kv = xk * kkw; const float ss = wave_sum(kv * kv); kkn[ii] = kv * rsqrtf(ss + L2_EPS);
                kt[ii] = xk * (1.f + (a - 1.f) * kaw); bb[ii] = kkn[ii] * a;
                run += ldv[ii]; lc[ii] = run; }
            GT[ig * 64 + c] = run;
        }
        LBAR();
        {
            float off = 0.f, tot = 0.f;
#pragma unroll
            for (int g = 0; g < 8; ++g) { const float gv = GT[g * 64 + c]; tot += gv; off += (g < ig) ? gv : 0.f; }
            const int i0 = ig * 8;
            float bd[8], kd[8];
            const float etot = __expf(tot); float egp = __expf(off);
#pragma unroll
            for (int ii = 0; ii < 8; ++ii) { const float gc = off + lc[ii]; const float eg = __expf(gc), ieg = __builtin_amdgcn_rcpf(eg), ed = etot * ieg;
                AT[(i0 + ii) * 72 + c] = bf1(-kkn[ii] * egp); egp = eg; BT[(i0 + ii) * 72 + c] = bf1(bb[ii] * ieg);
                KT[(i0 + ii) * 72 + c] = bf1(kt[ii] * ieg); QT[(i0 + ii) * 72 + c] = bf1(xr[ii] * eg);
                bd[ii] = bb[ii] * ed; kd[ii] = kt[ii] * ed; }
            v4u w;
            w.x = cvtpk(bd[0], bd[1]); w.y = cvtpk(bd[2], bd[3]); w.z = cvtpk(bd[4], bd[5]); w.w = cvtpk(bd[6], bd[7]); *(LAS v4u*)(BDt + c * 72 + i0) = w;
            w.x = cvtpk(kd[0], kd[1]); w.y = cvtpk(kd[2], kd[3]); w.z = cvtpk(kd[4], kd[5]); w.w = cvtpk(kd[6], kd[7]); *(LAS v4u*)(KDt + c * 72 + i0) = w;
            w.x = cvtpk(xv[0], xv[1]); w.y = cvtpk(xv[2], xv[3]); w.z = cvtpk(xv[4], xv[5]); w.w = cvtpk(xv[6], xv[7]); if ((c >> 5) == hf) *(LAS v4u*)(Vt + (c & 31) * 72 + i0) = w;
            if (ig == 0) GL[c] = etot;
        }
        LBAR();
#pragma unroll
        for (int nn = 0; nn < 5; ++nn) { const int jb = wave + 8 * nn, p = jb / 10; int ti, tj; lt_tile(jb % 10, ti, tj);
            const LAS bf16* X = (p < 2) ? AT : QT; const LAS bf16* Y = (p == 0 || p == 2) ? BT : KT;
            f32x4 acc = mm_tile<true, 64>(X, 72, Y, 72, ti, tj, (f32x4){0.f, 0.f, 0.f, 0.f}, r, q);
            const int i = 16 * ti + r, j0 = 16 * tj + 4 * q;
#pragma unroll
            for (int e = 0; e < 4; ++e) { const bool keep = (p < 2) ? (j0 + e < i) : (j0 + e <= i); acc[e] = keep ? acc[e] : 0.f; }
            if (p == 0) {
#pragma unroll
                for (int e = 0; e < 4; ++e) Ap[i * 68 + e * 16 + 4 * tj + q] = acc[e];
            } else { LAS bf16* O = (p == 1) ? Aak : (p == 2 ? Aqb : Aqk); *(LAS v2u*)(O + i * 72 + j0) = pk4(acc); } }
        LBAR();
        {
            const int chn = ch + 1 < SEQ / 64 ? ch + 1 : ch, trow = lq >> 3, tl = (lq & 7) < 5 ? (lq & 7) : 4; const size_t mrow = (size_t)b * SEQ + chn * 64 + ig * 8 + trow;
            const bf16* src = tl < 3 ? proj + mrow * PC + RW0 + h * 64 + tl * 512 : LO + mrow * LOC + h * 64 + (tl - 3) * 512;
            __builtin_amdgcn_global_load_lds((const unsigned*)src, (LAS unsigned*)(F.lds + 130560 + wave * 256), 4, 0, 0); }
        if (wave < 4) tri_solve(Ap, Tb, wave);
        else { const int wv = wave - 4; f32x4 racc[2];
#pragma unroll
            for (int u = 0; u < 2; ++u) { const int t = wv * 2 + u, ti = t >> 1, tj = t & 1;
                f32x4 ra = mm_tile<false, 64>(Aak, 72, Vt, 72, ti, tj, (f32x4){0.f, 0.f, 0.f, 0.f}, r, q); racc[u] = mm_tile<false, 64>(AT, 72, Ht, 72, ti, tj, ra, r, q);
                f32x4 ya = mm_tile<true, 64>(QT, 72, Ht, 72, ti, tj, (f32x4){0.f, 0.f, 0.f, 0.f}, r, q); yacc[u] = mm_tile<true, 64>(Aqk, 72, Vt, 72, ti, tj, ya, r, q);
                const f32x4 gl = *(const LAS f32x4*)(GL + 16 * ti + 4 * q);
                hacc[u] = mm_tile<false, 64>(KDt, 72, Vt, 72, ti, tj, hacc[u] * gl, r, q); }
#pragma unroll
            for (int u = 0; u < 2; ++u) { const int t = wv * 2 + u, ti = t >> 1, tj = t & 1; *(LAS v2u*)(Rt + (16 * tj + r) * 72 + 16 * ti + 4 * q) = pk4(racc[u]); } }
        LBAR();
        { const int t = wave, ti = t >> 1, tj = t & 1;
            const f32x4 ua = mm_tile<false, 64>(Tb, 72, Rt, 72, ti, tj, (f32x4){0.f, 0.f, 0.f, 0.f}, r, q);
            *(LAS v2u*)(Ut + (16 * tj + r) * 72 + 16 * ti + 4 * q) = pk4(ua); }
        LBAR();
        if (wave >= 4) { const int wv = wave - 4;
#pragma unroll
            for (int u = 0; u < 2; ++u) { const int t = wv * 2 + u, ti = t >> 1, tj = t & 1;
                yacc[u] = mm_tile<true, 64>(Aqb, 72, Ut, 72, ti, tj, yacc[u], r, q);
                hacc[u] = mm_tile<false, 64>(BDt, 72, Ut, 72, ti, tj, hacc[u], r, q); }
#pragma unroll
            for (int u = 0; u < 2; ++u) { const int t = wv * 2 + u, ti = t >> 1, tj = t & 1;
                *(v2u*)(OY + (m0 + 16 * ti + r) * D + 512 + h * 64 + hf * 32 + 16 * tj + 4 * q) = pk4(yacc[u]);
                *(LAS v2u*)(Ht + (16 * tj + r) * 72 + 16 * ti + 4 * q) = pk4(hacc[u]); } }
        LBAR();
    }
}

__device__ __forceinline__ void gdn_chunk_unit(Frame& F, int unit) {
    const int b = unit >> 4, h = (unit >> 2) & 3, sl = unit & 3, tid = F.tid, lane = F.lane, wave = F.wave;
    LAS bf16* QH = (LAS bf16*)F.lds; LAS bf16* KH = QH + 64 * 136; LAS bf16* KHt = KH + 64 * 136;
    LAS bf16* Aqk = KHt + 128 * 72; LAS bf16* Tb = Aqk + 4608; LAS bf16* Rt = Tb + 4608; LAS bf16* VNt = Rt + 32 * 72; LAS bf16* VNSt = VNt + 32 * 72;
    LAS bf16* St = VNSt + 32 * 72;
    LAS float* V32 = (LAS float*)(St + 32 * 136); LAS float* Ap = V32 + 64 * 32; LAS float* PS = Ap + 64 * 68;
    LAS float* GV = PS + 1024; LAS float* GC = GV + 64; LAS float* EGQ = GC + 64; LAS float* BE = EGQ + 64; LAS float* BEGK = BE + 64; LAS float* DLK = BEGK + 64; LAS float* SQ = DLK + 64; LAS float* SK = SQ + 64; LAS float* GLS = SK + 64;
    const bf16* proj = (const bf16*)(F.ws + WS_PROJ); const float* bg = (const float*)(F.ws + WS_BG); bf16* OY = (bf16*)(F.ws + WS_XN);
    const float* cw = F.in[9];
    const int cp = tid & 127, qt = tid >> 7, isk = cp >> 6, cq = (cp & 63) * 2, pcol = isk ? (512 + h * 128 + cq) : (h * 128 + cq);

    const int vd = tid & 31, vg = tid >> 5, vcol = 1024 + h * 128 + sl * 32 + vd;
    const float Ah = -expf(F.in[10][h]), dtb = F.in[11][h];
    for (int i = tid; i < 32 * 136 / 2; i += NTHREADS) ((LAS unsigned*)St)[i] = 0u;
    for (int i = tid; i < 4608 / 2; i += NTHREADS) ((LAS unsigned*)Aqk)[i] = 0u;
    f32x4 sacc[4], oacc[2];
#pragma unroll
    for (int u = 0; u < 4; ++u) sacc[u] = (f32x4){0.f, 0.f, 0.f, 0.f};
    unsigned xq[19]; bf16 xv_[7]; float bgb = 0.f, bga = 0.f;
#define GDN_LOAD(chn) do { const size_t mq = (size_t)b * SEQ + (chn) * 64 + qt * 16; const bf16* pq = proj + (mq - 3) * PC + pcol;     \
        _Pragma("unroll") for (int ii = 0; ii < 19; ++ii) { xq[ii] = *(const unsigned*)pq; pq += PC; asm volatile("" : "+v"(pq)); } \
        const size_t mv = (size_t)b * SEQ + (chn) * 64 + vg * 4; const bf16* pv = proj + (mv - 3) * PC + vcol; \
        _Pragma("unroll") for (int ii = 0; ii < 7; ++ii) { xv_[ii] = *pv; pv += PC; asm volatile("" : "+v"(pv)); } \
        if (tid < 64) { bgb = bg[((size_t)b * SEQ + (chn) * 64 + tid) * 8 + h]; bga = bg[((size_t)b * SEQ + (chn) * 64 + tid) * 8 + 4 + h]; } } while (0)
    __syncthreads();
    for (int ch = 0; ch < SEQ / 64; ++ch) {
        const int t0 = ch * 64; const size_t m0 = (size_t)b * SEQ + t0;
        const int lq = pg8::lane_id_opaque(), r = lq & 15, q = lq >> 4;
        GDN_LOAD(ch);
        const float cw0 = cw[pcol], cw1 = cw[1536 + pcol], cw2 = cw[2 * 1536 + pcol], cw3 = cw[3 * 1536 + pcol];
        const float dw0 = cw[pcol + 1], dw1 = cw[1536 + pcol + 1], dw2 = cw[2 * 1536 + pcol + 1], dw3 = cw[3 * 1536 + pcol + 1];
        const float vw0 = cw[vcol], vw1 = cw[1536 + vcol], vw2 = cw[2 * 1536 + vcol], vw3 = cw[3 * 1536 + vcol];
        {
            const int i0 = qt * 16; LAS bf16* dst = isk ? KH : QH;
            if (t0 + i0 == 0) { xq[0] = 0u; xq[1] = 0u; xq[2] = 0u; }
            float psa = 0.f;
#pragma unroll
            for (int g = 0; g < 2; ++g) { float a8[8], b8[8];
#pragma unroll
                for (int e = 0; e < 8; ++e) { const int ii = 8 * g + e;
                    a8[e] = silu_f(cw0 * bflo(xq[ii]) + cw1 * bflo(xq[ii + 1]) + cw2 * bflo(xq[ii + 2]) + cw3 * bflo(xq[ii + 3]));
                    b8[e] = silu_f(dw0 * bfhi(xq[ii]) + dw1 * bfhi(xq[ii + 1]) + dw2 * bfhi(xq[ii + 2]) + dw3 * bfhi(xq[ii + 3]));
                    const float ps = allsum16(a8[e] * a8[e] + b8[e] * b8[e]);
                    psa = (r == ii) ? ps : psa;
                    *(LAS unsigned*)(dst + (i0 + ii) * 136 + cq) = cvtpk(a8[e], b8[e]); }
                if (isk) { v4u w; w.x = cvtpk(a8[0], a8[1]); w.y = cvtpk(a8[2], a8[3]); w.z = cvtpk(a8[4], a8[5]); w.w = cvtpk(a8[6], a8[7]); *(LAS v4u*)(KHt + cq * 72 + i0 + 8 * g) = w;
                    w.x = cvtpk(b8[0], b8[1]); w.y = cvtpk(b8[2], b8[3]); w.z = cvtpk(b8[4], b8[5]); w.w = cvtpk(b8[6], b8[7]); *(LAS v4u*)(KHt + (cq + 1) * 72 + i0 + 8 * g) = w; } }
            PS[(isk * 4 + q) * 64 + i0 + r] = psa;
        }
        {
            const int i0 = vg * 4;
            float xm3 = bf2f(xv_[0]), xm2 = bf2f(xv_[1]), xm1 = bf2f(xv_[2]); if (t0 + i0 == 0) { xm3 = 0.f; xm2 = 0.f; xm1 = 0.f; }
#pragma unroll
            for (int ii = 0; ii < 4; ++ii) { const float x0 = bf2f(xv_[3 + ii]); V32[(i0 + ii) * 32 + vd] = silu_f(vw0 * xm3 + vw1 * xm2 + vw2 * xm1 + vw3 * x0); xm3 = xm2; xm2 = xm1; xm1 = x0; }
        }
        if (tid < 64) { BE[tid] = sigm_f(bgb); GV[tid] = Ah * softplus_f(bga + dtb); }
        LBAR();
        if (tid < 64) {
            float pre = GV[tid];
            pre += dpp_f<0x111>(pre); pre += dpp_f<0x112>(pre); pre += dpp_f<0x114>(pre); pre += dpp_f<0x118>(pre);
            const int ip = __builtin_bit_cast(int, pre);
            const float t0r = __builtin_bit_cast(float, __builtin_amdgcn_readlane(ip, 15)), t1r = __builtin_bit_cast(float, __builtin_amdgcn_readlane(ip, 31)), t2r = __builtin_bit_cast(float, __builtin_amdgcn_readlane(ip, 47)), t3r = __builtin_bit_cast(float, __builtin_amdgcn_readlane(ip, 63));
            pre += (q >= 1 ? t0r : 0.f) + (q >= 2 ? t1r : 0.f) + (q >= 3 ? t2r : 0.f);
            const float tot = (t0r + t1r) + (t2r + t3r);
            float s0 = 0.f, s1 = 0.f;
#pragma unroll
            for (int p = 0; p < 4; ++p) { s0 += PS[p * 64 + tid]; s1 += PS[(4 + p) * 64 + tid]; }
            const float eg = __expf(pre), sq = rsqrtf(s0 + L2_EPS) * 0.08838834764831845f, sk = rsqrtf(s1 + L2_EPS);
            GC[tid] = pre; SQ[tid] = sq; SK[tid] = sk; EGQ[tid] = eg * sq; BEGK[tid] = BE[tid] * eg * sk; DLK[tid] = __expf(tot - pre) * sk; if (tid == 0) GLS[0] = __expf(tot);
        }
        LBAR();
#pragma unroll
        for (int nn = 0; nn < 3; ++nn) { const int jb = wave + 8 * nn;
            if (jb < 20) { const int p = jb / 10; int ti, tj; lt_tile(jb % 10, ti, tj);
                f32x4 acc = mm_tile<true, 128>(p ? QH : KH, 136, KH, 136, ti, tj, (f32x4){0.f, 0.f, 0.f, 0.f}, r, q);
                const int i = 16 * ti + r, j0 = 16 * tj + 4 * q; const float gi = GC[i]; const f32x4 gj = *(const LAS f32x4*)(GC + j0);
                const f32x4 skj = *(const LAS f32x4*)(SK + j0);
                if (p == 0) { const float nb = -BE[i] * SK[i];
#pragma unroll
                    for (int e = 0; e < 4; ++e) Ap[i * 68 + e * 16 + 4 * tj + q] = (j0 + e < i) ? nb * skj[e] * acc[e] * __expf(gi - gj[e]) : 0.f;
                } else { const float sqi = SQ[i];
#pragma unroll
                    for (int e = 0; e < 4; ++e) acc[e] = (j0 + e <= i) ? sqi * skj[e] * acc[e] * __expf(gi - gj[e]) : 0.f;
                    *(LAS v2u*)(Aqk + i * 72 + j0) = pk4(acc); } } }
        LBAR();
        {
            const int chn = ch + 1 < SEQ / 64 ? ch + 1 : ch; const size_t mb = (size_t)b * SEQ + chn * 64;
            { const int L = lq < 38 ? lq : 37; const bf16* src = proj + (mb + qt * 16 - 3 + (L >> 1)) * PC + (isk ? 512 : 0) + h * 128 + (L & 1) * 64;
              __builtin_amdgcn_global_load_lds((const unsigned*)src, (LAS unsigned*)(F.lds + 126464 + wave * 256), 4, 0, 0); }
            { const size_t row = mb + wave * 8 + (lq & 7); const void* src = (lq >> 3) == 0 ? (const void*)(proj + row * PC + 1024 + h * 128 + sl * 32) : (const void*)(bg + row * 8);
              __builtin_amdgcn_global_load_lds((const unsigned*)src, (LAS unsigned*)(F.lds + 126464 + wave * 256), 4, 0, 0); } }
        if (wave < 4) tri_solve(Ap, Tb, wave);
        else { const int wv = wave - 4;
#pragma unroll
            for (int u = 0; u < 2; ++u) { const int t = wv * 2 + u, ti = t >> 1, tj = t & 1;
                const f32x4 ks = mm_tile<false, 128>(KH, 136, St, 136, ti, tj, (f32x4){0.f, 0.f, 0.f, 0.f}, r, q);
                f32x4 rv;
#pragma unroll
                for (int e = 0; e < 4; ++e) { const int i = 16 * ti + 4 * q + e; rv[e] = BE[i] * V32[i * 32 + 16 * tj + r] - BEGK[i] * ks[e]; }
                *(LAS v2u*)(Rt + (16 * tj + r) * 72 + 16 * ti + 4 * q) = pk4(rv);
                oacc[u] = mm_tile<true, 128>(QH, 136, St, 136, ti, tj, (f32x4){0.f, 0.f, 0.f, 0.f}, r, q) * EGQ[16 * ti + r]; } }
        LBAR();
        if (wave >= 4) { const int wv = wave - 4;
#pragma unroll
            for (int u = 0; u < 2; ++u) { const int t = wv * 2 + u, ti = t >> 1, tj = t & 1;
                const f32x4 vn = mm_tile<false, 64>(Tb, 72, Rt, 72, ti, tj, (f32x4){0.f, 0.f, 0.f, 0.f}, r, q);
                const f32x4 dl = *(const LAS f32x4*)(DLK + 16 * ti + 4 * q);
                *(LAS v2u*)(VNt + (16 * tj + r) * 72 + 16 * ti + 4 * q) = pk4(vn); *(LAS v2u*)(VNSt + (16 * tj + r) * 72 + 16 * ti + 4 * q) = pk4(vn * dl); } }
        LBAR();
        if (wave >= 4) { const int wv = wave - 4; const float gls = GLS[0];
#pragma unroll
            for (int u = 0; u < 2; ++u) { const int t = wv * 2 + u, ti = t >> 1, tj = t & 1;
                const f32x4 o = mm_tile<true, 64>(Aqk, 72, VNt, 72, ti, tj, oacc[u], r, q);
                *(v2u*)(OY + (m0 + 16 * ti + r) * D + h * 128 + sl * 32 + 16 * tj + 4 * q) = pk4(o); }
#pragma unroll
            for (int u = 0; u < 4; ++u) { const int t = wv * 4 + u, ti = t >> 1, tj = t & 1;
                sacc[u] = mm_tile<false, 64>(KHt, 72, VNSt, 72, ti, tj, sacc[u] * gls, r, q);
                *(LAS v2u*)(St + (16 * tj + r) * 136 + 16 * ti + 4 * q) = pk4(sacc[u]); } }
        LBAR();
    }
}

#define XB_TMO      128
#define XB_XCNT(j)  (256  + 64 * (j))
#define XB_XSUB(j)  (1280 + 64 * (j))
#define XB_XGEN(j)  (2304 + 64 * (j))
#define XB_TOP      3328
#define XB_TOPGEN   3392
#define XCD_BAR_WORDS 3456
#define XB_SPIN_CAP (1u << 18)

__device__ __forceinline__ unsigned xb_ld(unsigned* p)              { return __hip_atomic_load(p, __ATOMIC_RELAXED, __HIP_MEMORY_SCOPE_AGENT); }
__device__ __forceinline__ unsigned xb_add(unsigned* p, unsigned v) { return __hip_atomic_fetch_add(p, v, __ATOMIC_RELAXED, __HIP_MEMORY_SCOPE_AGENT); }
__device__ __forceinline__ unsigned xb_xcc_id() { return (unsigned)__builtin_amdgcn_s_getreg((3 << 11) | 20) & 0xFu; }
#define XB_SPIN(cond, bar) do { unsigned _sp = 0; while (cond) { __builtin_amdgcn_s_sleep(1); \
    if ((++_sp & 255u) == 0u) { if (xb_ld(&(bar)[XB_TMO])) break; if (_sp > XB_SPIN_CAP) { atomicAdd(&(bar)[XB_TMO], 1u); break; } } } } while (0)

struct XcdBarrier {
    unsigned* bar; unsigned x;
    volatile LAS unsigned* st;
};

__device__ __forceinline__ XcdBarrier xcd_barrier_post(unsigned* bar, volatile LAS unsigned* st) {
    XcdBarrier b; b.bar = bar; b.x = xb_xcc_id(); b.st = st;
    if (threadIdx.x == 0) (void)xb_add(&bar[XB_XCNT(b.x)], 1u);
    return b;
}
__device__ __forceinline__ void xcd_barrier_complete(unsigned* bar, unsigned x, unsigned& nloc, unsigned& nx) {
    const unsigned G = gridDim.x * gridDim.y * gridDim.z;
    unsigned sum, cnt, mine, sp = 0u;
    for (;;) {
        sum = 0u; cnt = 0u; mine = 0u;
#pragma unroll
        for (unsigned j = 0; j < 16; ++j) { const unsigned c = xb_ld(&bar[XB_XCNT(j)]); sum += c; cnt += (c > 0u) ? 1u : 0u; mine = (j == x) ? c : mine; }
        if (sum == G) break;
        __builtin_amdgcn_s_sleep(1);
        if ((++sp & 255u) == 0u) { if (xb_ld(&bar[XB_TMO])) break; if (sp > XB_SPIN_CAP) { atomicAdd(&bar[XB_TMO], 1u); break; } }
    }
    nloc = mine > 0u ? mine : 1u; nx = cnt > 0u ? cnt : 1u;
}

__device__ __forceinline__ void xcd_barrier(const XcdBarrier& b) {
    asm volatile("s_waitcnt vmcnt(0)" ::: "memory");
    __syncthreads();
    if (threadIdx.x == 0) {
        unsigned* bar = b.bar;
        __builtin_amdgcn_s_waitcnt(0);
        unsigned nloc = b.st[0], nx = b.st[1];
        if (nloc == 0u) { xcd_barrier_complete(bar, b.x, nloc, nx); b.st[0] = nloc; b.st[1] = nx; }
        const unsigned old = xb_add(&bar[XB_XSUB(b.x)], 1u);
        const unsigned gen = old / nloc;
        if (old + 1u == (gen + 1u) * nloc) {
            __builtin_amdgcn_fence(__ATOMIC_RELEASE, "agent");
            asm volatile("s_waitcnt vmcnt(0)" ::: "memory");
            const unsigned og = xb_add(&bar[XB_TOP], 1u);
            const unsigned tg = og / nx;
            if (og + 1u == (tg + 1u) * nx) xb_add(&bar[XB_TOPGEN], 1u);
            else XB_SPIN(xb_ld(&bar[XB_TOPGEN]) == tg, bar);
            __builtin_amdgcn_fence(__ATOMIC_ACQUIRE, "agent");
            xb_add(&bar[XB_XGEN(b.x)], 1u);
            asm volatile("s_waitcnt vmcnt(0)" ::: "memory");
        } else {
            XB_SPIN(xb_ld(&bar[XB_XGEN(b.x)]) == gen, bar);
            __builtin_amdgcn_fence(__ATOMIC_ACQUIRE, "agent");
            asm volatile("s_waitcnt vmcnt(0)" ::: "memory");
        }
    }
    __syncthreads();
}

__device__ __forceinline__ void gbar_counter(unsigned* cnt, unsigned target, int tid) {
    asm volatile("s_waitcnt vmcnt(0)" ::: "memory");
    __syncthreads();
    if (tid == 0) {
        __builtin_amdgcn_fence(__ATOMIC_RELEASE, "agent");
        asm volatile("s_waitcnt vmcnt(0)" ::: "memory");
        __hip_atomic_fetch_add(cnt, 1u, __ATOMIC_RELAXED, __HIP_MEMORY_SCOPE_AGENT);
        while (__hip_atomic_load(cnt, __ATOMIC_RELAXED, __HIP_MEMORY_SCOPE_AGENT) < target) __builtin_amdgcn_s_sleep(2);
        __builtin_amdgcn_fence(__ATOMIC_ACQUIRE, "agent");
        asm volatile("s_waitcnt vmcnt(0)" ::: "memory");
    }
    __syncthreads();
}

__global__ void __launch_bounds__(NTHREADS, 2) mega_fwd(Args args) {
    extern __shared__ __attribute__((aligned(16))) unsigned char lds[];
    cg::grid_group grid = cg::this_grid();
    Frame F;
    F.lds = (LAS unsigned char*)lds; F.wave = __builtin_amdgcn_readfirstlane((int)threadIdx.x >> 6); F.G = gridDim.x;
#define REFRESH() do { F.lane = pg8::lane_id_opaque(); F.tid = F.wave * 64 + F.lane; } while (0)
    REFRESH();
    F.in = args.in; F.out = args.out; F.ws = args.ws;
    unsigned char* ws = args.ws;
    bf16* XN = (bf16*)(ws + WS_XN); bf16* H = (bf16*)(ws + WS_H); bf16* Fm = (bf16*)(ws + WS_F); bf16* PROJ = (bf16*)(ws + WS_PROJ); bf16* Tm = (bf16*)(ws + WS_T);
    bf16* LO = (bf16*)(ws + WS_LO); bf16* LA = (bf16*)(ws + WS_LA); float* BG = (float*)(ws + WS_BG);
    const int bx = (int)blockIdx.x;
    bf16* XB = (bf16*)F.out;
    bf16* XB3 = (bf16*)(ws + WS_XB3);
    unsigned* barw = (unsigned*)(ws + WS_BAR);
    volatile LAS unsigned* MISC = (volatile LAS unsigned*)(F.lds + 147200);
    if (F.tid < 32) MISC[F.tid] = 0u;
    if (bx == 0) for (int i = F.tid; i < XCD_BAR_WORDS; i += NTHREADS) barw[i] = 0u;
    __syncthreads();
    XcdBarrier xbar; xbar.bar = barw; xbar.x = 0; xbar.st = MISC + 8;
    bool xb_ready = false;

#ifndef PROBE_MASK
#define PROBE_MASK 0
#endif
#ifdef TS_PROBE
#define TSX(k, blk) do { if (bx == (blk) && F.tid == 0) ((unsigned long long*)(ws + WS_BG + 2 * MiB))[k] = __builtin_amdgcn_s_memrealtime(); } while (0)
#define STAMP(k) do { if (bx == 0 && F.tid == 0) ((unsigned long long*)(ws + WS_BG + 2 * MiB))[k] = __builtin_amdgcn_s_memrealtime(); } while (0)
#else
#define TSX(k, blk) do { } while (0)
#define STAMP(k) do { } while (0)
#endif
#define RUN(k, ...) for (int rep_ = 0; rep_ < (((PROBE_MASK) >> (k)) & 1) + 1; ++rep_) { __VA_ARGS__; if (!xb_ready) { grid.sync(); xbar = xcd_barrier_post(barw, MISC + 8); xb_ready = true; } else xcd_barrier(xbar); REFRESH(); STAMP((k) + 1); }
    STAMP(0);
    RUN(0, p0_prologue(F))
    RUN(1, { pg8::Gemm g{XN, (const bf16*)(ws + WS_WGU1), M, 2 * DFF, D, D}; pg8::StaticOrder S; S.init(M, 2 * DFF, F.G, bx); pg8::EpiSwiglu E{H, HLD};
      pg8::gemm_phase<pg8::EpiSwiglu, pg8::StaticOrder, true, true>(F.lds, g, S, E, F.wave); })
    RUN(2, { pg8::Gemm g{H, (const bf16*)(ws + WS_WD1), M, D, DFF, HLD}; pg8::StaticOrder S; S.init(M, D, F.G, bx); S.rev = 1; pg8::EpiBf16<0> E{Fm, D, nullptr, 0, 0, 1.f};
      pg8::gemm_phase<pg8::EpiBf16<0>, pg8::StaticOrder, true, true>(F.lds, g, S, E, F.wave); })
    RUN(3, row_phase<true, true, false, true>(F, Fm, F.in[0], XB, 0.5f, F.in[6], F.in[7], XN, F.in[8], BG))
    RUN(4, { pg8::Gemm g{XN, (const bf16*)(ws + WS_WIN), M, PC, D, D}; pg8::StaticOrder S; S.init(M, PC, F.G, bx); pg8::EpiBf16<0> E{PROJ, PC, nullptr, 0, 0, 1.f};
      pg8::gemm_phase<pg8::EpiBf16<0>, pg8::StaticOrder, true, true>(F.lds, g, S, E, F.wave); })
    RUN(5, lora_in_phase(F))
    RUN(6, { pg8::Gemm g{LA, (const bf16*)(ws + WS_WL), M, LOC, 256, 256}; pg8::StaticOrder S; S.init(M, LOC, F.G, bx); pg8::EpiBf16<0> E{LO, LOC, nullptr, 0, 0, 1.f};
      pg8::gemm_phase<pg8::EpiBf16<0>, pg8::StaticOrder, true, true>(F.lds, g, S, E, F.wave); })
    RUN(7, { const bool xa = (F.G == 256);
        for (int u = bx; u < 128; u += F.G) { const int xc = u & 7, kk_ = u >> 3; gdn_chunk_unit(F, xa ? (((xc * 4 + (kk_ >> 2)) << 2) | (kk_ & 3)) : u); } REFRESH(); TSX(20, 0);
        for (int u = bx; u < 256; u += F.G) if (u >= 128) { const int j_ = u - 128, xc = j_ & 7, kk_ = j_ >> 3; rwkv_chunk_unit(F, xa ? (((xc * 8 + (kk_ >> 1)) << 1) | (kk_ & 1)) : j_); } REFRESH(); TSX(21, 128);
        late_prologue(F, 0, xa ? 128 : F.G); })
    RUN(8, mixer_post_phase(F))
    RUN(9, { pg8::Gemm g{XN, (const bf16*)(ws + WS_WOUT), M, D, D, D}; pg8::StaticOrder S; S.init(M, D, F.G, bx); pg8::EpiBf16<0> E{Fm, D, nullptr, 0, 0, 1.f};
      pg8::gemm_phase<pg8::EpiBf16<0>, pg8::StaticOrder, true, true>(F.lds, g, S, E, F.wave); })
    RUN(10, { row_phase<true, false, true, true>(F, Fm, XB, XB, 1.0f, F.in[25], F.in[26], XN, nullptr, nullptr);
})
    RUN(11, { pg8::Gemm g{XN, (const bf16*)(ws + WS_WGU2), M, 2 * DFF, D, D}; pg8::StaticOrder S; S.init(M, 2 * DFF, F.G, bx); pg8::EpiSwiglu E{H, HLD};
      pg8::gemm_phase<pg8::EpiSwiglu, pg8::StaticOrder, true, true>(F.lds, g, S, E, F.wave); })
    RUN(12, { pg8::Gemm g{H, (const bf16*)(ws + WS_WD2), M, D, DFF, HLD}; pg8::StaticOrder S; S.init(M, D, F.G, bx); S.rev = 1; pg8::EpiBf16<0> E{Fm, D, nullptr, 0, 0, 1.f};
      pg8::gemm_phase<pg8::EpiBf16<0>, pg8::StaticOrder, true, true>(F.lds, g, S, E, F.wave); })
    RUN(13, { row_phase<true, false, true, true>(F, Fm, XB, XB3, 0.5f, F.in[30], F.in[31], XN, nullptr, nullptr); REFRESH();
      { pg8::Gemm g{LA, (const bf16*)(ws + WS_WPP), M, D, DPLE, DPLE}; pg8::StaticOrder S; S.init(M, D, F.G, bx); pg8::EpiBf16<0> E{Tm, D, nullptr, 0, 0, 1.f};
      pg8::gemm_phase<pg8::EpiBf16<0>, pg8::StaticOrder, true, true>(F.lds, g, S, E, F.wave); } })
    RUN(14, { pg8::Gemm g{XN, (const bf16*)(ws + WS_WPG), M, D, D, D}; pg8::StaticOrder S; S.init(M, D, F.G, bx); pg8::EpiPle E{Fm, Tm, D};
      pg8::gemm_phase<pg8::EpiPle, pg8::StaticOrder, true, true>(F.lds, g, S, E, F.wave); })
    row_phase<false, false, true, false>(F, Fm, XB3, F.out, 1.0f, F.in[34], nullptr, nullptr, nullptr, nullptr);
#ifdef TS_PROBE
    grid.sync(); REFRESH();
    if (bx == 0) { const unsigned long long* ts = (const unsigned long long*)(ws + WS_BG + 2 * MiB);
        const int n = (TS_A < 0) ? 2000 : (int)((ts[TS_B] - ts[TS_A]) / 100ull);
        for (int i = F.tid; i < n; i += NTHREADS) F.out[i] += 0.5f;
#ifdef TS_C
        if (F.tid == 0) { const unsigned long long t0 = __builtin_amdgcn_s_memrealtime(), span = (ts[TS_D] - ts[TS_C]) * 4ull;
            while (__builtin_amdgcn_s_memrealtime() - t0 < span) __builtin_amdgcn_s_sleep(8); }
#endif
    }
#endif
}

extern "C" void kernel_launch(void* const* d_in, const int* in_sizes, int n_in, void* d_out, int out_size, void* d_ws, size_t ws_size, hipStream_t stream) {
    static int grid = 0;
    if (grid == 0) {
        if (n_in != 35 || in_sizes[0] != M * D || out_size != M * D || ws_size < WS_END) { fprintf(stderr, "kernel_launch: unexpected shapes: n_in %d in0 %d out %d ws %zu; nothing launched\n", n_in, n_in > 0 ? in_sizes[0] : -1, out_size, ws_size); grid = -1; return; }
        int dev = 0, cus = 0, per_cu = 0;
        hipGetDevice(&dev); hipDeviceGetAttribute(&cus, hipDeviceAttributeMultiprocessorCount, dev);
        if (hipFuncSetAttribute((const void*)mega_fwd, hipFuncAttributeMaxDynamicSharedMemorySize, LDS_BYTES) != hipSuccess) { fprintf(stderr, "kernel_launch: hipFuncSetAttribute failed\n"); grid = -1; return; }
        if (hipOccupancyMaxActiveBlocksPerMultiprocessor(&per_cu, (const void*)mega_fwd, NTHREADS, LDS_BYTES) != hipSuccess || per_cu < 1) { fprintf(stderr, "kernel_launch: occupancy query says %d\n", per_cu); per_cu = 1; }
        (void)hipGetLastError();
        grid = cus;
    }
    if (grid < 0) return;
    Args a{};
    for (int i = 0; i < 35; ++i) a.in[i] = (const float*)d_in[i];
    a.out = (float*)d_out; a.ws = (unsigned char*)d_ws;
    void* kargs[] = {&a};
    hipError_t e = hipLaunchCooperativeKernel((const void*)mega_fwd, dim3(grid), dim3(NTHREADS), kargs, LDS_BYTES, stream);
    if (e != hipSuccess) fprintf(stderr, "kernel_launch: cooperative launch failed: %s (grid %d)\n", hipGetErrorString(e), grid);
}
```

```cpp
#include <hip/hip_runtime.h>
#include <hip/hip_cooperative_groups.h>
#include <cstdio>
#include <cstdint>
namespace cg = cooperative_groups;
namespace pg8 {
#define PG8_LAS __attribute__((address_space(3)))
typedef unsigned short bf16_t;
typedef short bf16x8 __attribute__((ext_vector_type(8)));
typedef float f32x4 __attribute__((ext_vector_type(4)));
typedef unsigned u32x4 __attribute__((ext_vector_type(4)));
constexpr int BM = 256, BK = 64, HALF = 128, HTB = HALF * BK * 2  , STAGE_BYTES = 8 * HTB, NXCD = 8, WGM = 8;

__host__ __device__ __forceinline__ int lds_byte(int r, int c) { const int st = (r >> 4) * 2 + (c >> 5), rr = r & 15, cc = c & 31, ob = rr * 64 + cc * 2; return st * 1024 + (ob ^ (((ob >> 9) & 1) << 5)); }
__host__ __device__ __forceinline__ void stage_rc(int b, int& R, int& C) { const int st = b / 1024, sb = b % 1024, swz = sb ^ (((sb >> 9) & 1) << 5); R = (st >> 1) * 16 + swz / 64; C = (st & 1) * 32 + (swz % 64) / 2; }
__host__ __device__ __forceinline__ int perm32(int rho) { const int n = rho >> 4, i = rho & 15; return 8 * (i >> 2) + 4 * n + (i & 3); }

struct Unit { int pm, pn; };
struct Gemm { const bf16_t* A; const bf16_t* Bt; int M, N, K, LD; };

struct StaticOrder {
    int nM, nN, nwg, G, c, rev;
    __host__ __device__ void init(int M, int N, int G_, int c_) { nM = M / BM; nN = N / BM; nwg = nM * nN; G = G_; c = c_; rev = 0; }
    __host__ __device__ bool next(int i, Unit& u) const {
        const long L = (long)i * G + c; if (L >= nwg) return false;
        int wgid = (int)L; { const int q = nwg / NXCD, r = nwg % NXCD, xcd = wgid % NXCD, off = wgid / NXCD; wgid = (xcd < r ? xcd * (q + 1) : r * (q + 1) + (xcd - r) * q) + off; }
        const int nig = WGM * nN, gid = wgid / nig, fm = gid * WGM, gsz = (nM - fm) < WGM ? (nM - fm) : WGM;
        u.pm = fm + ((wgid % nig) % gsz); u.pn = (wgid % nig) / gsz; if (rev) u.pm = nM - 1 - u.pm; return true;
    }
    __device__ __forceinline__ void a_ready(const Unit&) const {}
    __device__ __forceinline__ void done(const Unit&) const {}
};

__device__ __forceinline__ unsigned cvt_pk_bf16(float lo, float hi) { unsigned r; asm volatile("v_cvt_pk_bf16_f32 %0, %1, %2" : "=v"(r) : "v"(lo), "v"(hi)); return r; }
typedef float f32x2 __attribute__((ext_vector_type(2)));
__device__ __forceinline__ f32x2 gelu_pk(f32x2 v) {
    const f32x2 av = __builtin_elementwise_abs(v), d = av * 0.2316418882f + 1.0f;
    f32x2 t; t.x = __builtin_amdgcn_rcpf(d.x); t.y = __builtin_amdgcn_rcpf(d.y);
    f32x2 q = t * 0.5307027145f + (-0.7265760135f); q = q * t + 0.7107068705f; q = q * t + (-0.142248368f); q = q * t + 0.127414796f; q = q * t;
    const f32x2 s = (v * v) * (-0.72134752044f);
    f32x2 e; e.x = __builtin_amdgcn_exp2f(s.x); e.y = __builtin_amdgcn_exp2f(s.y);
    const f32x2 m = v * (q * e), r = v - m;
    f32x2 o; o.x = v.x < 0.f ? m.x : r.x; o.y = v.y < 0.f ? m.y : r.y; return o;
}

template <int ACT  > struct EpiBf16 {
    static constexpr bool PERM = true, AFTER_DRAIN = false; static_assert(ACT == 0 || ACT == 1, "EpiBf16: ACT is 0 (none) or 1 (gelu_pk)");
    bf16_t* O; int ldc; const float* bias; int split_cols; size_t split_stride; float scale0;
    __device__ __forceinline__ void operator()(const f32x4 (&acc)[2][2][4][2], const Unit& u, int wr, int wc, int fr, int fq) const {
        const int row0 = u.pm * BM + wr * 64 + fr; int colt = u.pn * BM; bf16_t* base = O;
        float sc = 1.f; if (split_cols) { const int t = colt / split_cols; base += (size_t)t * split_stride; colt -= t * split_cols; if (t == 0) sc = scale0; }
        const int col0 = colt + wc * 32 + 8 * fq, bcol0 = u.pn * BM + wc * 32 + 8 * fq;
        f32x4 bv[2][2];
#pragma unroll
        for (int bj = 0; bj < 2; ++bj)
#pragma unroll
            for (int n = 0; n < 2; ++n) bv[bj][n] = bias ? *(const f32x4*)(bias + bcol0 + bj * HALF + 4 * n) : (f32x4){0.f, 0.f, 0.f, 0.f};
#pragma unroll
        for (int ai = 0; ai < 2; ++ai)
#pragma unroll
            for (int m = 0; m < 4; ++m) { bf16_t* rowp = base + (size_t)(row0 + ai * HALF + m * 16) * ldc + col0;
#pragma unroll
                for (int bj = 0; bj < 2; ++bj) { f32x4 v0 = acc[ai][bj][m][0] + bv[bj][0], v1 = acc[ai][bj][m][1] + bv[bj][1];
                    if (ACT == 1) { f32x2 a = gelu_pk((f32x2){v0[0], v0[1]}), b = gelu_pk((f32x2){v0[2], v0[3]}), c = gelu_pk((f32x2){v1[0], v1[1]}), d = gelu_pk((f32x2){v1[2], v1[3]});
                        v0 = (f32x4){a.x, a.y, b.x, b.y}; v1 = (f32x4){c.x, c.y, d.x, d.y}; }
                    v0 = v0 * sc; v1 = v1 * sc; u32x4 w; w.x = cvt_pk_bf16(v0[0], v0[1]); w.y = cvt_pk_bf16(v0[2], v0[3]); w.z = cvt_pk_bf16(v1[0], v1[1]); w.w = cvt_pk_bf16(v1[2], v1[3]);
                    *(u32x4*)(rowp + bj * HALF) = w; } }
    }
};
__device__ __forceinline__ int lane_id_opaque() { int l; asm volatile("v_mbcnt_lo_u32_b32 %0, -1, 0\n\tv_mbcnt_hi_u32_b32 %0, -1, %0" : "=v"(l)); return l; }
__device__ __forceinline__ float sigmoid_f(float x) { return __builtin_amdgcn_rcpf(1.f + __expf(-x)); }
struct EpiF32 {
    static constexpr bool PERM = false, AFTER_DRAIN = false;
    float* C; int ldc;
    __device__ __forceinline__ void operator()(const f32x4 (&acc)[2][2][4][2], const Unit& u, int wr, int wc, int fr, int fq) const {
        const int row0 = u.pm * BM + wr * 64 + fr, col0 = u.pn * BM + wc * 32 + 4 * fq;
#pragma unroll
        for (int ai = 0; ai < 2; ++ai)
#pragma unroll
            for (int m = 0; m < 4; ++m) { float* rowp = C + (size_t)(row0 + ai * HALF + m * 16) * ldc + col0;
#pragma unroll
                for (int bj = 0; bj < 2; ++bj)
#pragma unroll
                    for (int n = 0; n < 2; ++n) *(f32x4*)(rowp + bj * HALF + n * 16) = acc[ai][bj][m][n]; }
    }
};
struct EpiSwiglu {
    static constexpr bool PERM = true, AFTER_DRAIN = false;
    bf16_t* O; int ldc;
    __device__ __forceinline__ void operator()(const f32x4 (&acc)[2][2][4][2], const Unit& u, int wr, int wc, int fr, int fq) const {
        const int row0 = u.pm * BM + wr * 64 + fr, col0 = u.pn * HALF + wc * 32 + 8 * fq;
#pragma unroll
        for (int ai = 0; ai < 2; ++ai)
#pragma unroll
            for (int m = 0; m < 4; ++m) { bf16_t* rowp = O + (size_t)(row0 + ai * HALF + m * 16) * ldc + col0;
                f32x4 h0, h1;
#pragma unroll
                for (int e = 0; e < 4; ++e) { const float g0 = acc[ai][0][m][0][e], g1 = acc[ai][0][m][1][e];
                    h0[e] = g0 * sigmoid_f(g0) * acc[ai][1][m][0][e]; h1[e] = g1 * sigmoid_f(g1) * acc[ai][1][m][1][e]; }
                u32x4 w; w.x = cvt_pk_bf16(h0[0], h0[1]); w.y = cvt_pk_bf16(h0[2], h0[3]); w.z = cvt_pk_bf16(h1[0], h1[1]); w.w = cvt_pk_bf16(h1[2], h1[3]);
                *(u32x4*)rowp = w; }
    }
};
struct EpiPle {
    static constexpr bool PERM = false, AFTER_DRAIN = false;
    bf16_t* C; const bf16_t* T; int ldc;
    __device__ __forceinline__ void operator()(const f32x4 (&acc)[2][2][4][2], const Unit& u, int wr, int wc, int fr, int fq) const {
        typedef unsigned u32x2 __attribute__((ext_vector_type(2)));
        const int row0 = u.pm * BM + wr * 64 + fr, col0 = u.pn * BM + wc * 32 + 4 * fq;
#pragma unroll
        for (int ai = 0; ai < 2; ++ai)
#pragma unroll
            for (int m = 0; m < 4; ++m) { const size_t off = (size_t)(row0 + ai * HALF + m * 16) * ldc + col0;
#pragma unroll
                for (int bj = 0; bj < 2; ++bj)
#pragma unroll
                    for (int n = 0; n < 2; ++n) { const u32x2 t = *(const u32x2*)(T + off + bj * HALF + n * 16); const f32x4 a = acc[ai][bj][m][n];
                        f32x4 o; o[0] = sigmoid_f(a[0]) * __uint_as_float(t.x << 16); o[1] = sigmoid_f(a[1]) * __uint_as_float(t.x & 0xffff0000u);
                        o[2] = sigmoid_f(a[2]) * __uint_as_float(t.y << 16); o[3] = sigmoid_f(a[3]) * __uint_as_float(t.y & 0xffff0000u);
                        u32x2 w; w.x = cvt_pk_bf16(o[0], o[1]); w.y = cvt_pk_bf16(o[2], o[3]); *(u32x2*)(C + off + bj * HALF + n * 16) = w; } }
    }
};
template <class Epi, class Sched, bool ALIGN_EPI = false, bool SP2 = false>
__device__ __forceinline__ void gemm_phase(PG8_LAS unsigned char* lds, const Gemm g, const Sched& S, const Epi& E, int wave_id) {
    int tid_ = wave_id * 64 + lane_id_opaque();
    const int tid = tid_, wid = __builtin_amdgcn_readfirstlane(tid >> 6), lane = tid & 63, wr = wid >> 2, wc = wid & 3, fr = lane & 15, fq = lane >> 4;
    const int K = g.K, nt = K / BK, LD = g.LD;
    unsigned voffA[2], voffB[2];
#pragma unroll
    for (int i = 0; i < 2; ++i) { int R, C; stage_rc(tid * 16 + i * 8192, R, C); const int Rb = Epi::PERM ? ((R & ~31) + perm32(R & 31)) : R;
        voffA[i] = (unsigned)(R * LD + C) * 2u; voffB[i] = (unsigned)(Rb * LD + C) * 2u; }
    const size_t kstep = (size_t)(BK * 2);
    const size_t hstep = (size_t)HALF * LD * 2;
    const size_t tstep = 2 * hstep;
    const unsigned ldsw = (unsigned)wid * 1024u;
    const int aoff = lds_byte(wr * 64 + fr, fq * 8), boff = lds_byte(wc * 32 + fr, fq * 8);
#define PG8_SA(b, h) (((b) * 2 + (h)) * HTB)
#define PG8_SB(b, h) ((4 + (b) * 2 + (h)) * HTB)
#define PG8_STAGE(bufoff, gbase, voff) do { _Pragma("unroll") for (int _i = 0; _i < 2; ++_i) \
        __builtin_amdgcn_global_load_lds((const unsigned*)((const char*)(gbase) + (voff)[_i]), (PG8_LAS unsigned*)(lds + (bufoff) + ldsw + _i * 8192), 16, 0, 0); } while (0)
#define PG8_LDA(dst, b, h) do { _Pragma("unroll") for (int m = 0; m < 4; ++m) _Pragma("unroll") for (int k = 0; k < 2; ++k) dst[m][k] = *(const PG8_LAS bf16x8*)(lds + PG8_SA(b, h) + aoff + m * 2048 + k * 1024); } while (0)
#define PG8_LDB(dst, b, h) do { _Pragma("unroll") for (int n = 0; n < 2; ++n) _Pragma("unroll") for (int k = 0; k < 2; ++k) dst[n][k] = *(const PG8_LAS bf16x8*)(lds + PG8_SB(b, h) + boff + n * 2048 + k * 1024); } while (0)
#define PG8_MMA(ai, bj, At, Bt) do { __builtin_amdgcn_s_setprio(1); _Pragma("unroll") for (int m = 0; m < 4; ++m) _Pragma("unroll") for (int n = 0; n < 2; ++n) _Pragma("unroll") for (int k = 0; k < 2; ++k) \
        acc[ai][bj][m][n] = __builtin_amdgcn_mfma_f32_16x16x32_bf16(Bt[n][k], At[m][k], acc[ai][bj][m][n], 0, 0, 0); __builtin_amdgcn_s_setprio(0); } while (0)
#define PG8_WAIT_V(n) asm volatile("s_waitcnt vmcnt(" #n ")" ::: "memory")
#define PG8_WAIT_L(n) asm volatile("s_waitcnt lgkmcnt(" #n ")" ::: "memory")
#define PG8_BAR __builtin_amdgcn_s_barrier()
#define PG8_SCHED __builtin_amdgcn_sched_barrier(0)
    Unit cur, nxt; int ui = 0;
    if (!S.next(0, cur)) return;
    f32x4 acc[2][2][4][2];
#pragma unroll
    for (int a = 0; a < 2; ++a)
#pragma unroll
        for (int b = 0; b < 2; ++b)
#pragma unroll
            for (int m = 0; m < 4; ++m)
#pragma unroll
                for (int n = 0; n < 2; ++n) acc[a][b][m][n] = (f32x4){0.f, 0.f, 0.f, 0.f};
    bf16x8 At[4][2], B0[2][2], B1[2][2];
    const char* cA = (const char*)g.A + (size_t)cur.pm * tstep; const char* cB = (const char*)g.Bt + (size_t)cur.pn * tstep;
    S.a_ready(cur);
    if constexpr (SP2) {
        PG8_STAGE(PG8_SB(0, 0), cB, voffB); PG8_STAGE(PG8_SB(0, 1), cB + hstep, voffB); PG8_STAGE(PG8_SA(0, 0), cA, voffA); PG8_STAGE(PG8_SA(0, 1), cA + hstep, voffA);
        if (wr == 1) PG8_BAR;
        PG8_WAIT_V(2); PG8_BAR;
        PG8_STAGE(PG8_SB(1, 0), cB + kstep, voffB); PG8_STAGE(PG8_SA(1, 0), cA + kstep, voffA); PG8_STAGE(PG8_SB(1, 1), cB + hstep + kstep, voffB);
        PG8_WAIT_V(6); PG8_BAR;
    } else {
        PG8_STAGE(PG8_SB(0, 0), cB, voffB); PG8_STAGE(PG8_SA(0, 0), cA, voffA); PG8_STAGE(PG8_SB(0, 1), cB + hstep, voffB); PG8_STAGE(PG8_SA(0, 1), cA + hstep, voffA);
        if (wr == 1) PG8_BAR;
        PG8_WAIT_V(4); PG8_BAR;
        PG8_STAGE(PG8_SB(1, 0), cB + kstep, voffB); PG8_STAGE(PG8_SA(1, 0), cA + kstep, voffA); PG8_STAGE(PG8_SB(1, 1), cB + hstep + kstep, voffB);
        PG8_WAIT_V(6); PG8_BAR;
    }
    for (;;) {
        const bool has_next = S.next(ui + 1, nxt);
        const char* nA = has_next ? (const char*)g.A + (size_t)nxt.pm * tstep : cA; const char* nB = has_next ? (const char*)g.Bt + (size_t)nxt.pn * tstep : cB;
        for (int t = 0; t < nt; t += 2) {
            const bool last = (t == nt - 2);
            const char* a1 = cA + (size_t)(t + 1) * kstep;
            const char* a2 = last ? nA : cA + (size_t)(t + 2) * kstep; const char* b2 = last ? nB : cB + (size_t)(t + 2) * kstep;
            const char* a3 = a2 + kstep; const char* b3 = b2 + kstep;
            if (last && has_next) S.a_ready(nxt);
            if constexpr (SP2) {
            PG8_LDB(B0, 0, 0); PG8_LDB(B1, 0, 1); PG8_SCHED; PG8_LDA(At, 0, 0); PG8_STAGE(PG8_SA(1, 1), a1 + hstep, voffA);
            PG8_WAIT_V(8); PG8_WAIT_L(0); PG8_BAR; PG8_MMA(0, 0, At, B0); PG8_MMA(0, 1, At, B1); PG8_BAR; PG8_SCHED;
            PG8_LDA(At, 0, 1); PG8_STAGE(PG8_SB(0, 0), b2, voffB); PG8_STAGE(PG8_SB(0, 1), b2 + hstep, voffB); PG8_STAGE(PG8_SA(0, 0), a2, voffA);
            PG8_WAIT_V(8); PG8_WAIT_L(0); PG8_BAR; PG8_MMA(1, 0, At, B0); PG8_MMA(1, 1, At, B1); PG8_BAR; PG8_SCHED;
            PG8_LDB(B0, 1, 0); PG8_LDB(B1, 1, 1); PG8_SCHED; PG8_LDA(At, 1, 0); PG8_STAGE(PG8_SA(0, 1), a2 + hstep, voffA);
            PG8_WAIT_V(8); PG8_WAIT_L(0); PG8_BAR; PG8_MMA(0, 0, At, B0); PG8_MMA(0, 1, At, B1); PG8_BAR; PG8_SCHED;
            PG8_LDA(At, 1, 1); PG8_STAGE(PG8_SB(1, 0), b3, voffB); PG8_STAGE(PG8_SB(1, 1), b3 + hstep, voffB); PG8_STAGE(PG8_SA(1, 0), a3, voffA);
            PG8_WAIT_V(8); PG8_WAIT_L(0); PG8_BAR; PG8_MMA(1, 0, At, B0); PG8_MMA(1, 1, At, B1); PG8_BAR; PG8_SCHED;
            } else {
            PG8_LDB(B0, 0, 0); PG8_SCHED; PG8_LDA(At, 0, 0); PG8_STAGE(PG8_SA(1, 1), a1 + hstep, voffA);
            PG8_WAIT_L(8); PG8_BAR; PG8_WAIT_L(0); PG8_MMA(0, 0, At, B0); PG8_BAR; PG8_SCHED;
            PG8_LDB(B1, 0, 1); PG8_STAGE(PG8_SB(0, 0), b2, voffB);
            PG8_BAR; PG8_WAIT_L(0); PG8_MMA(0, 1, At, B1); PG8_BAR;
            PG8_LDA(At, 0, 1); PG8_STAGE(PG8_SA(0, 0), a2, voffA);
            PG8_BAR; PG8_WAIT_L(0); PG8_MMA(1, 0, At, B0); PG8_BAR; PG8_SCHED;
            PG8_STAGE(PG8_SB(0, 1), b2 + hstep, voffB);
            PG8_WAIT_V(6); PG8_BAR; PG8_MMA(1, 1, At, B1); PG8_BAR;
            PG8_LDB(B0, 1, 0); PG8_SCHED; PG8_LDA(At, 1, 0); PG8_STAGE(PG8_SA(0, 1), a2 + hstep, voffA);
            PG8_WAIT_L(8); PG8_BAR; PG8_WAIT_L(0); PG8_MMA(0, 0, At, B0); PG8_BAR; PG8_SCHED;
            PG8_LDB(B1, 1, 1); PG8_STAGE(PG8_SB(1, 0), b3, voffB);
            PG8_BAR; PG8_WAIT_L(0); PG8_MMA(0, 1, At, B1); PG8_BAR;
            PG8_LDA(At, 1, 1); PG8_STAGE(PG8_SA(1, 0), a3, voffA);
            PG8_BAR; PG8_WAIT_L(0); PG8_MMA(1, 0, At, B0); PG8_BAR; PG8_SCHED;
            PG8_STAGE(PG8_SB(1, 1), b3 + hstep, voffB);
            PG8_WAIT_V(6); PG8_BAR; PG8_MMA(1, 1, At, B1); PG8_BAR;
            }
        }
        if constexpr (ALIGN_EPI) { if (wr == 0) PG8_BAR; }
        if constexpr (!Epi::AFTER_DRAIN) { E(acc, cur, wr, wc, fr, fq); S.done(cur); }
        if (!has_next) break;
#pragma unroll
        for (int a = 0; a < 2; ++a)
#pragma unroll
            for (int b = 0; b < 2; ++b)
#pragma unroll
                for (int m = 0; m < 4; ++m)
#pragma unroll
                    for (int n = 0; n < 2; ++n) acc[a][b][m][n] = (f32x4){0.f, 0.f, 0.f, 0.f};
        cur = nxt; cA = nA; cB = nB; ++ui;
        if constexpr (ALIGN_EPI) { if (wr == 1) PG8_BAR; }
    }
    PG8_WAIT_V(0);
    if constexpr (!ALIGN_EPI) { if (wr == 0) PG8_BAR; }
    PG8_BAR;
    if constexpr (Epi::AFTER_DRAIN) { E.fused(acc, cur, wr, wc, fr, fq, lds, wid, lane); S.done(cur); }
#undef PG8_SA
#undef PG8_SB
#undef PG8_STAGE
#undef PG8_LDA
#undef PG8_LDB
#undef PG8_MMA
#undef PG8_WAIT_V
#undef PG8_WAIT_L
#undef PG8_BAR
#undef PG8_SCHED
}
}
constexpr int NWAVES = 8, NTHREADS = 512;
constexpr int BATCH = 8, SEQ = 4096, D = 1024, M = BATCH * SEQ, DFF = 2816, DPLE = 256;
constexpr int HLD = 2880  , IN_COLS = 3848, PC = 3840  , RW0 = 2048  , LOC = 1536;
constexpr float NORM_EPS = 1e-6f, GN_EPS = 64e-5f, L2_EPS = 1e-6f;
constexpr size_t MiB = 1u << 20;
constexpr size_t WS_WGU1 = 0, WS_WD1 = 11 * MiB, WS_WGU2 = 17 * MiB, WS_WD2 = 28 * MiB, WS_WIN = 34 * MiB, WS_WOUT = 42 * MiB, WS_WPG = 44 * MiB, WS_WPP = 46 * MiB, WS_WL = 46 * MiB + 512 * 1024;
constexpr size_t WS_XN = 48 * MiB;
constexpr size_t WS_PROJ = 112 * MiB;
constexpr size_t WS_H = 112 * MiB;
constexpr size_t WS_T = 112 * MiB;
constexpr size_t WS_F = 352 * MiB;
constexpr size_t WS_LO = 352 * MiB;
constexpr size_t WS_LA = 480 * MiB;
constexpr size_t WS_BG = 496 * MiB;
constexpr size_t WS_XB3 = 192 * MiB;
constexpr size_t WS_BAR = 500 * MiB;
constexpr size_t WS_END = 512 * MiB;
constexpr int LDS_BYTES = 147456;

#define LAS __attribute__((address_space(3)))
typedef unsigned short bf16;
typedef unsigned v4u __attribute__((ext_vector_type(4)));
typedef unsigned v2u __attribute__((ext_vector_type(2)));
typedef float f32x4 __attribute__((ext_vector_type(4)));
#define LDS_WAIT() asm volatile("s_waitcnt lgkmcnt(0)" ::: "memory")
typedef float f32x2v_ __attribute__((ext_vector_type(2)));
typedef __bf16 bf16x2v_ __attribute__((ext_vector_type(2)));
__device__ __forceinline__ unsigned pk2(float lo, float hi) { const f32x2v_ v = {lo, hi}; const bf16x2v_ b = __builtin_convertvector(v, bf16x2v_); return __builtin_bit_cast(unsigned, b); }
__device__ __forceinline__ unsigned f2bf(float f) { return pk2(f, 0.f) & 0xffffu; }
__device__ __forceinline__ float bf2f(bf16 v) { return __uint_as_float((unsigned)v << 16); }
__device__ __forceinline__ float bflo(unsigned w) { return __uint_as_float(w << 16); }
__device__ __forceinline__ float bfhi(unsigned w) { return __uint_as_float(w & 0xffff0000u); }
__device__ __forceinline__ float sigm(float x) { return __builtin_amdgcn_rcpf(1.f + __expf(-x)); }
__device__ __forceinline__ float silu(float x) { return x * sigm(x); }
__device__ __forceinline__ float softplus(float x) { return fmaxf(x, 0.f) + log1pf(expf(-fabsf(x))); }
template <int CTRL> __device__ __forceinline__ float dpp_f(float v) { return __builtin_bit_cast(float, __builtin_amdgcn_update_dpp(0, __builtin_bit_cast(int, v), CTRL, 0xF, 0xF, true)); }
__device__ __forceinline__ float allsum4(float v) { v += dpp_f<0xB1>(v); v += dpp_f<0x4E>(v); return v; }
__device__ __forceinline__ float allsum8(float v) { v = allsum4(v); v += dpp_f<0x141>(v); return v; }
__device__ __forceinline__ float allsum16(float v) { v = allsum8(v); v += dpp_f<0x140>(v); return v; }

__device__ __forceinline__ float wave_sum(float v) {
    v = allsum16(v);
    v += __builtin_bit_cast(float, __builtin_amdgcn_update_dpp(0, __builtin_bit_cast(int, v), 0x142, 0xA, 0xF, false));
    v += __builtin_bit_cast(float, __builtin_amdgcn_update_dpp(0, __builtin_bit_cast(int, v), 0x143, 0xC, 0xF, false));
    return __builtin_bit_cast(float, __builtin_amdgcn_readlane(__builtin_bit_cast(int, v), 63));
}

struct Args { const float* in[35]; float* out; unsigned char* ws; };

struct Frame {
    LAS unsigned char* lds;
    int tid, lane, wave, G;
    const float* const* in;
    float* out; unsigned char* ws;
};

__device__ __forceinline__ void transpose_item(const float* W, int ld, int K, bf16* WT, int k0, int sn0, int dr0, LAS float* scr, int lane, int pitch) {
    float tv[32];
#pragma unroll
    for (int i = 0; i < 32; ++i) { const int kk = 2 * i + (lane >> 5); tv[i] = W[(size_t)(k0 + kk) * ld + sn0 + (lane & 31)]; }
#pragma unroll
    for (int i = 0; i < 32; ++i) { const int kk = 2 * i + (lane >> 5); scr[kk * 33 + (lane & 31)] = tv[i]; }
    LDS_WAIT(); asm volatile("" ::: "memory");
    const int c = lane & 7;
#pragma unroll
    for (int j = 0; j < 4; ++j) { const int n = (lane >> 3) + 8 * j; const LAS float* s = scr + (8 * c) * 33 + n;
        v4u o; o.x = pk2(s[0 * 33], s[1 * 33]); o.y = pk2(s[2 * 33], s[3 * 33]); o.z = pk2(s[4 * 33], s[5 * 33]); o.w = pk2(s[6 * 33], s[7 * 33]);
        *(v4u*)(WT + (size_t)(dr0 + n) * pitch + k0 + 8 * c) = o; }
    LDS_WAIT(); asm volatile("" ::: "memory");
}
template <int MODE> __device__ __forceinline__ void transpose_mat(Frame& F, const float* W, int K, int ld, int nblk, int sn_base, int dr_base, bf16* WT, int& it, int gw, int NGW, int& base, int pitch) {
    const int nitems = (K / 64) * nblk;
    LAS float* scr = (LAS float*)(F.lds + F.wave * 16384);
    for (; it < base + nitems; it += NGW) { const int r = it - base, kb = r / nblk, nb = r % nblk, n0 = 32 * nb;
        int dr = dr_base + n0;
        if (MODE == 1) dr = 256 * (n0 >> 7) + (n0 & 127);
        if (MODE == 2) dr = 256 * (n0 >> 7) + 128 + (n0 & 127);
        transpose_item(W, ld, K, WT, 64 * kb, sn_base + n0, dr, scr, F.lane, pitch); }
    base += nitems;
}
__device__ __forceinline__ void p0_prologue(Frame& F) {
    const int gw = blockIdx.x * NWAVES + F.wave, NGW = F.G * NWAVES;
    unsigned char* ws = F.ws;
    int it = gw, base = 0;
    transpose_mat<1>(F, F.in[3], D, DFF, DFF / 32, 0, 0, (bf16*)(ws + WS_WGU1), it, gw, NGW, base, D);
    transpose_mat<2>(F, F.in[4], D, DFF, DFF / 32, 0, 0, (bf16*)(ws + WS_WGU1), it, gw, NGW, base, D);
    transpose_mat<0>(F, F.in[5], DFF, D, D / 32, 0, 0, (bf16*)(ws + WS_WD1), it, gw, NGW, base, HLD);
    transpose_mat<0>(F, F.in[8], D, IN_COLS, 64, 0, 0, (bf16*)(ws + WS_WIN), it, gw, NGW, base, D);
    transpose_mat<0>(F, F.in[8], D, IN_COLS, 56, 2056, 2048, (bf16*)(ws + WS_WIN), it, gw, NGW, base, D);
    { bf16* WL = (bf16*)(ws + WS_WL); const float* w2 = F.in[15]; const float* a2 = F.in[17]; const float* g2 = F.in[18];
      for (int idx = blockIdx.x * NTHREADS + F.tid; idx < LOC * 256; idx += F.G * NTHREADS) { const int n = idx >> 8, k = idx & 255; float v = 0.f;
          if (n < 512) { if (k < 64) v = w2[k * 512 + n]; }
          else if (n < 1024) { if (k >= 64 && k < 128) v = a2[(k - 64) * 512 + (n - 512)]; }
          else { if (k >= 128) v = g2[(k - 128) * 512 + (n - 1024)]; }
          WL[idx] = (bf16)f2bf(v); } }
    { const float* x = F.in[0]; const float* g = F.in[2]; bf16* XN = (bf16*)(ws + WS_XN);
      f32x4 gv[4];
#pragma unroll
      for (int j = 0; j < 4; ++j) gv[j] = ((const f32x4*)g)[F.lane + 64 * j];
      for (int m = gw; m < M; m += NGW) { const f32x4* xr = (const f32x4*)(x + (size_t)m * D) + F.lane; f32x4 v[4]; float s = 0.f;
#pragma unroll
          for (int j = 0; j < 4; ++j) { v[j] = __builtin_nontemporal_load(xr + 64 * j); s += (v[j].x * v[j].x + v[j].y * v[j].y) + (v[j].z * v[j].z + v[j].w * v[j].w); }
          const float rstd = rsqrtf(wave_sum(s) * (1.f / D) + NORM_EPS);
          v2u* o8 = (v2u*)(XN + (size_t)m * D) + F.lane;
#pragma unroll
          for (int j = 0; j < 4; ++j) { const f32x4 o = v[j] * rstd * gv[j]; v2u w; w.x = pk2(o.x, o.y); w.y = pk2(o.z, o.w); o8[64 * j] = w; } } }
}

__device__ __forceinline__ void late_prologue(Frame& F, int first, int count) {
    const int nb = count; if (nb <= 0 || (int)blockIdx.x < first || (int)blockIdx.x >= first + count) return;
    const int gw = ((int)blockIdx.x - first) * NWAVES + F.wave, NGW = nb * NWAVES;
    unsigned char* ws = F.ws;
    int it = gw, base = 0;
    transpose_mat<1>(F, F.in[27], D, DFF, DFF / 32, 0, 0, (bf16*)(ws + WS_WGU2), it, gw, NGW, base, D);
    transpose_mat<2>(F, F.in[28], D, DFF, DFF / 32, 0, 0, (bf16*)(ws + WS_WGU2), it, gw, NGW, base, D);
    transpose_mat<0>(F, F.in[29], DFF, D, D / 32, 0, 0, (bf16*)(ws + WS_WD2), it, gw, NGW, base, HLD);
    transpose_mat<0>(F, F.in[24], D, D, D / 32, 0, 0, (bf16*)(ws + WS_WOUT), it, gw, NGW, base, D);
    transpose_mat<0>(F, F.in[32], D, D, D / 32, 0, 0, (bf16*)(ws + WS_WPG), it, gw, NGW, base, D);
    transpose_mat<0>(F, F.in[33], DPLE, D, D / 32, 0, 0, (bf16*)(ws + WS_WPP), it, gw, NGW, base, DPLE);
    { const float* p = F.in[1]; v2u* P16 = (v2u*)(ws + WS_LA);
      for (int idx = ((int)blockIdx.x - first) * NTHREADS + F.tid; idx < M * DPLE / 4; idx += nb * NTHREADS) { const f32x4 v = ((const f32x4*)p)[idx]; v2u w; w.x = pk2(v.x, v.y); w.y = pk2(v.z, v.w); P16[idx] = w; } }
}

template <bool DO_XN, bool DO_BG, bool RIN16, bool ROUT16>
__device__ __forceinline__ void row_phase(Frame& F, const bf16* Fm, const void* resid, void* xout, float scale, const float* gpost, const float* gpre, bf16* XN, const float* w_in, float* bg) {
    const int gw = blockIdx.x * NWAVES + F.wave, NGW = F.G * NWAVES;
    LAS float* W8 = (LAS float*)F.lds;
    if (DO_BG) { for (int idx = F.tid; idx < 8192; idx += NTHREADS) W8[idx] = w_in[(size_t)(idx >> 3) * IN_COLS + 2048 + (idx & 7)]; __syncthreads(); }
    f32x4 gp[4], gq[4];
#pragma unroll
    for (int j = 0; j < 4; ++j) { gp[j] = ((const f32x4*)gpost)[F.lane + 64 * j] * scale; if (DO_XN) gq[j] = ((const f32x4*)gpre)[F.lane + 64 * j]; }
    for (int m = gw; m < M; m += NGW) {
        const v2u* fr = (const v2u*)(Fm + (size_t)m * D) + F.lane;
        f32x4 v[4], r[4]; float s = 0.f;
#pragma unroll
        for (int j = 0; j < 4; ++j) { const v2u fw = fr[64 * j]; v[j] = (f32x4){bflo(fw.x), bfhi(fw.x), bflo(fw.y), bfhi(fw.y)};
            if (RIN16) { const v2u rw = ((const v2u*)((const bf16*)resid + (size_t)m * D) + F.lane)[64 * j]; r[j] = (f32x4){bflo(rw.x), bfhi(rw.x), bflo(rw.y), bfhi(rw.y)}; }
            else r[j] = __builtin_nontemporal_load((const f32x4*)((const float*)resid + (size_t)m * D) + F.lane + 64 * j);
            s += (v[j].x * v[j].x + v[j].y * v[j].y) + (v[j].z * v[j].z + v[j].w * v[j].w); }
        const float rstd = rsqrtf(wave_sum(s) * (1.f / D) + NORM_EPS);
        float s2 = 0.f;
#pragma unroll
        for (int j = 0; j < 4; ++j) { v[j] = r[j] + v[j] * rstd * gp[j];
            if (ROUT16) { v2u w; w.x = pk2(v[j].x, v[j].y); w.y = pk2(v[j].z, v[j].w); ((v2u*)((bf16*)xout + (size_t)m * D) + F.lane)[64 * j] = w; }
            else __builtin_nontemporal_store(v[j], (f32x4*)((float*)xout + (size_t)m * D) + F.lane + 64 * j);
            s2 += (v[j].x * v[j].x + v[j].y * v[j].y) + (v[j].z * v[j].z + v[j].w * v[j].w); }
        if (DO_XN) {
            const float rstd2 = rsqrtf(wave_sum(s2) * (1.f / D) + NORM_EPS);
            v2u* o8 = (v2u*)(XN + (size_t)m * D) + F.lane;
#pragma unroll
            for (int j = 0; j < 4; ++j) { v[j] = v[j] * rstd2 * gq[j]; v2u w; w.x = pk2(v[j].x, v[j].y); w.y = pk2(v[j].z, v[j].w); o8[64 * j] = w; }
            if (DO_BG) {
                float a8[8];
#pragma unroll
                for (int q = 0; q < 8; ++q) a8[q] = 0.f;
#pragma unroll
                for (int j = 0; j < 4; ++j)
#pragma unroll
                    for (int e = 0; e < 4; ++e) { const int k = 4 * F.lane + 256 * j + e; const f32x4 wa = *(const LAS f32x4*)(W8 + k * 8), wb = *(const LAS f32x4*)(W8 + k * 8 + 4); const float xv = v[j][e];
                        a8[0] += xv * wa.x; a8[1] += xv * wa.y; a8[2] += xv * wa.z; a8[3] += xv * wa.w; a8[4] += xv * wb.x; a8[5] += xv * wb.y; a8[6] += xv * wb.z; a8[7] += xv * wb.w; }
#pragma unroll
                for (int q = 0; q < 8; ++q) a8[q] = wave_sum(a8[q]);
                if (F.lane == 0) { *(f32x4*)(bg + (size_t)m * 8) = (f32x4){a8[0], a8[1], a8[2], a8[3]}; *(f32x4*)(bg + (size_t)m * 8 + 4) = (f32x4){a8[4], a8[5], a8[6], a8[7]}; }
            }
        }
    }
}

__device__ __forceinline__ void lora_in_phase(Frame& F) {
    const bf16* proj = (const bf16*)(F.ws + WS_PROJ); bf16* LA = (bf16*)(F.ws + WS_LA); const float* mu = F.in[13];
    const int w_ = F.wave, l_ = F.lane;
    const int cp = w_ < 4 ? (w_ >> 1) * 32 + (l_ & 31) : 64 + l_, tq = w_ < 4 ? (w_ & 1) * 2 + (l_ >> 5) : w_ - 4, c = 2 * cp;
    const float mu0 = mu[1536 + c], mu1 = mu[1536 + c + 1];
    for (int tile = blockIdx.x; tile < M / 64; tile += F.G) {
        const size_t mrow = (size_t)tile * 64 + tq * 16; const int t = (int)(mrow & (SEQ - 1));
        const bf16* pp = proj + mrow * PC + RW0 + 1536 + c;
        unsigned w[17];
        w[0] = t > 0 ? *(const unsigned*)(pp - PC) : 0u;
#pragma unroll
        for (int ii = 0; ii < 16; ++ii) w[ii + 1] = *(const unsigned*)(pp + (size_t)ii * PC);
#pragma unroll
        for (int ii = 0; ii < 16; ++ii) { const float c0 = bflo(w[ii + 1]), c1 = bfhi(w[ii + 1]), p0 = bflo(w[ii]), p1 = bfhi(w[ii]);
            const float x0 = c0 + (p0 - c0) * mu0, x1 = c1 + (p1 - c1) * mu1;
            float v0, v1;
            if (w_ < 2) { v0 = tanhf(x0); v1 = tanhf(x1); } else if (w_ < 4) { v0 = x0; v1 = x1; } else { v0 = sigm(x0); v1 = sigm(x1); }
            *(unsigned*)(LA + (mrow + ii) * 256 + c) = pk2(v0, v1); }
    }
}

__device__ __forceinline__ void gdn_scan_unit(Frame& F, int unit) {
    const int b = unit >> 4, h = (unit >> 2) & 3, sl = unit & 3, tid = F.tid;
    LAS float* QK = (LAS float*)F.lds;
    LAS float* V = QK + 32 * 256;
    LAS float* SC = V + 32 * 32;
    LAS float* OB = SC + 64;
    const bf16* proj = (const bf16*)(F.ws + WS_PROJ); const float* bg = (const float*)(F.ws + WS_BG); bf16* OY = (bf16*)(F.ws + WS_XN);
    const float* cw = F.in[9];
    const int col = tid >> 4, kq = tid & 15;
    float s[8];
#pragma unroll
    for (int e = 0; e < 8; ++e) s[e] = 0.f;
    const int c = tid & 255, hf = tid >> 8, pcol = c < 128 ? (h * 128 + c) : (512 + h * 128 + (c - 128));
    const float cw0 = cw[pcol], cw1 = cw[1536 + pcol], cw2 = cw[2 * 1536 + pcol], cw3 = cw[3 * 1536 + pcol];
    const int vi = tid >> 4, vd = (tid & 15) * 2, vcol = 1024 + h * 128 + sl * 32 + vd;
    float vw[4][2];
#pragma unroll
    for (int j = 0; j < 4; ++j) { vw[j][0] = cw[j * 1536 + vcol]; vw[j][1] = cw[j * 1536 + vcol + 1]; }
    const float Ah = -expf(F.in[10][h]), dtb = F.in[11][h];
    for (int blk = 0; blk < SEQ / 32; ++blk) {
        const int t0 = blk * 32; const size_t m0 = (size_t)b * SEQ + t0;
        {
            const int i0 = hf * 16; const bf16* pp = proj + (m0 + i0) * PC + pcol;
            float xm3 = 0.f, xm2 = 0.f, xm1 = 0.f;
            if (t0 + i0 > 0) { xm3 = bf2f(pp[-3 * PC]); xm2 = bf2f(pp[-2 * PC]); xm1 = bf2f(pp[-1 * PC]); }
#pragma unroll
            for (int ii = 0; ii < 16; ++ii) { const float x0 = bf2f(pp[(size_t)ii * PC]); const float y = cw0 * xm3 + cw1 * xm2 + cw2 * xm1 + cw3 * x0; QK[(i0 + ii) * 256 + c] = silu(y); xm3 = xm2; xm2 = xm1; xm1 = x0; }
        }
        {
            float a0 = 0.f, a1 = 0.f;
#pragma unroll
            for (int j = 0; j < 4; ++j) { const int t = t0 + vi - 3 + j; if (t >= 0) { const unsigned w = *(const unsigned*)(proj + ((size_t)b * SEQ + t) * PC + vcol); a0 += vw[j][0] * bflo(w); a1 += vw[j][1] * bfhi(w); } }
            V[vi * 32 + vd] = silu(a0); V[vi * 32 + vd + 1] = silu(a1);
        }
        if (tid < 32) { const float bv = bg[(m0 + tid) * 8 + h], av = bg[(m0 + tid) * 8 + 4 + h]; SC[tid * 2] = sigm(bv); SC[tid * 2 + 1] = expf(Ah * softplus(av + dtb)); }
        __syncthreads();
        {
            const int vid = tid >> 3, i = vid >> 1, which = vid & 1, sub = tid & 7; LAS f32x4* p = (LAS f32x4*)(QK + i * 256 + which * 128 + sub * 16);
            f32x4 a = p[0], b4 = p[1], c4 = p[2], d4 = p[3];
            float ss = (a.x * a.x + a.y * a.y + a.z * a.z + a.w * a.w) + (b4.x * b4.x + b4.y * b4.y + b4.z * b4.z + b4.w * b4.w) + (c4.x * c4.x + c4.y * c4.y + c4.z * c4.z + c4.w * c4.w) + (d4.x * d4.x + d4.y * d4.y + d4.z * d4.z + d4.w * d4.w);
            ss = allsum8(ss);
            const float sc = rsqrtf(ss + L2_EPS) * (which == 0 ? 0.08838834764831845f : 1.f);
            p[0] = a * sc; p[1] = b4 * sc; p[2] = c4 * sc; p[3] = d4 * sc;
        }
        __syncthreads();
#pragma unroll 4
        for (int i = 0; i < 32; ++i) {
            const f32x4 k0 = *(const LAS f32x4*)(QK + i * 256 + 128 + kq * 8), k1 = *(const LAS f32x4*)(QK + i * 256 + 128 + kq * 8 + 4);
            const f32x4 q0 = *(const LAS f32x4*)(QK + i * 256 + kq * 8), q1 = *(const LAS f32x4*)(QK + i * 256 + kq * 8 + 4);
            const float vj = V[i * 32 + col], beta = SC[2 * i], eg = SC[2 * i + 1];
            float dot = (k0.x * s[0] + k0.y * s[1] + k0.z * s[2] + k0.w * s[3]) + (k1.x * s[4] + k1.y * s[5] + k1.z * s[6] + k1.w * s[7]);
            dot = allsum16(dot);
            const float c1 = beta * (vj - eg * dot);
            s[0] = k0.x * c1 + eg * s[0]; s[1] = k0.y * c1 + eg * s[1]; s[2] = k0.z * c1 + eg * s[2]; s[3] = k0.w * c1 + eg * s[3];
            s[4] = k1.x * c1 + eg * s[4]; s[5] = k1.y * c1 + eg * s[5]; s[6] = k1.z * c1 + eg * s[6]; s[7] = k1.w * c1 + eg * s[7];
            float o = (q0.x * s[0] + q0.y * s[1] + q0.z * s[2] + q0.w * s[3]) + (q1.x * s[4] + q1.y * s[5] + q1.z * s[6] + q1.w * s[7]);
            o = allsum16(o);
            if (kq == 0) OB[i * 32 + col] = o;
        }
        __syncthreads();
        *(unsigned*)(OY + (m0 + vi) * D + h * 128 + sl * 32 + vd) = pk2(OB[vi * 32 + vd], OB[vi * 32 + vd + 1]);
    }
    __syncthreads();
}

__device__ __forceinline__ void rwkv_scan_unit(Frame& F, int unit) {
    const int b = unit >> 4, h = (unit >> 1) & 7, rh = unit & 1, tid = F.tid;
    LAS float* R = (LAS float*)F.lds;
    LAS float* W = R + 2048; LAS float* K = W + 2048; LAS float* KK = K + 2048; LAS float* BB = KK + 2048;
    LAS float* V = BB + 2048;
    LAS float* YB = V + 1024;
    const bf16* proj = (const bf16*)(F.ws + WS_PROJ); const bf16* LO = (const bf16*)(F.ws + WS_LO); bf16* OY = (bf16*)(F.ws + WS_XN);
    const float* mu = F.in[13];
    const int row = tid >> 4, kq = tid & 15;
    float s[4] = {0.f, 0.f, 0.f, 0.f};
    const int k = F.lane, ig = F.wave, cr = h * 64 + k;
    const float mu_r = mu[cr], mu_k = mu[512 + cr], mu_v = mu[1024 + cr], kkw = F.in[19][cr], kaw = F.in[20][cr], w0c = F.in[14][cr], a0c = F.in[16][cr];
    const int vi = tid >> 4, vd = (tid & 15) * 2;
    for (int blk = 0; blk < SEQ / 32; ++blk) {
        const int t0 = blk * 32; const size_t m0 = (size_t)b * SEQ + t0;
        {
            const int i0 = ig * 4; const bf16* pp = proj + (m0 + i0) * PC + RW0 + cr;
            float pr = 0.f, pk = 0.f, pv = 0.f;
            if (t0 + i0 > 0) { pr = bf2f(pp[-PC]); pk = bf2f(pp[-PC + 512]); pv = bf2f(pp[-PC + 1024]); }
#pragma unroll
            for (int ii = 0; ii < 4; ++ii) { const int i = i0 + ii; const bf16* q = pp + (size_t)ii * PC;
                const float cr_ = bf2f(q[0]), ck_ = bf2f(q[512]), cv_ = bf2f(q[1024]);
                const float xr = cr_ + (pr - cr_) * mu_r, xk = ck_ + (pk - ck_) * mu_k, xv = cv_ + (pv - cv_) * mu_v; pr = cr_; pk = ck_; pv = cv_;
                const float zw = w0c + bf2f(LO[(m0 + i) * LOC + cr]), a = sigm(a0c + bf2f(LO[(m0 + i) * LOC + 512 + cr]));
                const float ld = -expf(-softplus(-zw) - 0.5f);
                const float kv = xk * kkw; const float ss = wave_sum(kv * kv); const float kkn = kv * rsqrtf(ss + L2_EPS);
                R[i * 64 + k] = xr; W[i * 64 + k] = expf(ld); K[i * 64 + k] = xk * (1.f + (a - 1.f) * kaw); KK[i * 64 + k] = kkn; BB[i * 64 + k] = kkn * a;
                if ((k >> 5) == rh) V[i * 32 + (k & 31)] = xv; }
        }
        __syncthreads();
#pragma unroll 4
        for (int i = 0; i < 32; ++i) {
            const f32x4 kk4 = *(const LAS f32x4*)(KK + i * 64 + kq * 4), w4 = *(const LAS f32x4*)(W + i * 64 + kq * 4), b4 = *(const LAS f32x4*)(BB + i * 64 + kq * 4);
            const f32x4 k4 = *(const LAS f32x4*)(K + i * 64 + kq * 4), r4 = *(const LAS f32x4*)(R + i * 64 + kq * 4);
            const float v = V[i * 32 + row];
            float sa = -((kk4.x * s[0] + kk4.y * s[1]) + (kk4.z * s[2] + kk4.w * s[3]));
            sa = allsum16(sa);
            s[0] = s[0] * w4.x + sa * b4.x + v * k4.x; s[1] = s[1] * w4.y + sa * b4.y + v * k4.y; s[2] = s[2] * w4.z + sa * b4.z + v * k4.z; s[3] = s[3] * w4.w + sa * b4.w + v * k4.w;
            float y = (s[0] * r4.x + s[1] * r4.y) + (s[2] * r4.z + s[3] * r4.w);
            y = allsum16(y);
            if (kq == 0) YB[i * 32 + row] = y;
        }
        __syncthreads();
        *(unsigned*)(OY + (m0 + vi) * D + 512 + h * 64 + rh * 32 + vd) = pk2(YB[vi * 32 + vd], YB[vi * 32 + vd + 1]);
    }
    __syncthreads();
}

__device__ __forceinline__ void mixer_post_phase(Frame& F) {
    const int gw = blockIdx.x * NWAVES + F.wave, NGW = F.G * NWAVES, lane = F.lane;
    const bf16* proj = (const bf16*)(F.ws + WS_PROJ); const bf16* LO = (const bf16*)(F.ws + WS_LO); bf16* OY = (bf16*)(F.ws + WS_XN);
    const float* mu = F.in[13];
    const int gd = (lane & 15) * 8, gcol = (lane >> 4) * 128 + gd;
    const int rcol = (lane >> 3) * 64 + (lane & 7) * 8;
    float gnw[8], mur[8], muk[8], muv[8], ka[8], rk[8], gw8[8], gb8[8], a0v[8];
#pragma unroll
    for (int e = 0; e < 8; ++e) { gnw[e] = F.in[12][gd + e]; mur[e] = mu[rcol + e]; muk[e] = mu[512 + rcol + e]; muv[e] = mu[1024 + rcol + e]; ka[e] = F.in[20][rcol + e]; rk[e] = F.in[21][rcol + e]; gw8[e] = F.in[22][rcol + e]; gb8[e] = F.in[23][rcol + e]; a0v[e] = F.in[16][rcol + e]; }
    for (int m = gw; m < M; m += NGW) {
        const int t = m & (SEQ - 1);
        { const v4u ow = *(const v4u*)(OY + (size_t)m * D + gcol); const v4u zw = *(const v4u*)(proj + (size_t)m * PC + 1536 + gcol);
          float o[8] = {bflo(ow.x), bfhi(ow.x), bflo(ow.y), bfhi(ow.y), bflo(ow.z), bfhi(ow.z), bflo(ow.w), bfhi(ow.w)};
          float z[8] = {bflo(zw.x), bfhi(zw.x), bflo(zw.y), bfhi(zw.y), bflo(zw.z), bfhi(zw.z), bflo(zw.w), bfhi(zw.w)};
          float ss = 0.f;
#pragma unroll
          for (int e = 0; e < 8; ++e) ss += o[e] * o[e];
          ss = allsum16(ss); const float rstd = rsqrtf(ss * (1.f / 128.f) + NORM_EPS);
#pragma unroll
          for (int e = 0; e < 8; ++e) o[e] = o[e] * rstd * gnw[e] * silu(z[e]);
          v4u w; w.x = pk2(o[0], o[1]); w.y = pk2(o[2], o[3]); w.z = pk2(o[4], o[5]); w.w = pk2(o[6], o[7]);
          *(v4u*)(OY + (size_t)m * D + gcol) = w; }
        { const v4u yw = *(const v4u*)(OY + (size_t)m * D + 512 + rcol);
          const bf16* pc = proj + (size_t)m * PC + RW0 + rcol;
          const v4u rw_ = *(const v4u*)pc, kw_ = *(const v4u*)(pc + 512), vw_ = *(const v4u*)(pc + 1024);
          v4u prw = (v4u){0u, 0u, 0u, 0u}, pkw = prw, pvw = prw;
          if (t > 0) { prw = *(const v4u*)(pc - PC); pkw = *(const v4u*)(pc - PC + 512); pvw = *(const v4u*)(pc - PC + 1024); }
          const v4u aw = *(const v4u*)(LO + (size_t)m * LOC + 512 + rcol), gw_ = *(const v4u*)(LO + (size_t)m * LOC + 1024 + rcol);
          float y[8] = {bflo(yw.x), bfhi(yw.x), bflo(yw.y), bfhi(yw.y), bflo(yw.z), bfhi(yw.z), bflo(yw.w), bfhi(yw.w)};
          float rc[8] = {bflo(rw_.x), bfhi(rw_.x), bflo(rw_.y), bfhi(rw_.y), bflo(rw_.z), bfhi(rw_.z), bflo(rw_.w), bfhi(rw_.w)};
          float kc[8] = {bflo(kw_.x), bfhi(kw_.x), bflo(kw_.y), bfhi(kw_.y), bflo(kw_.z), bfhi(kw_.z), bflo(kw_.w), bfhi(kw_.w)};
          float vc[8] = {bflo(vw_.x), bfhi(vw_.x), bflo(vw_.y), bfhi(vw_.y), bflo(vw_.z), bfhi(vw_.z), bflo(vw_.w), bfhi(vw_.w)};
          float rp[8] = {bflo(prw.x), bfhi(prw.x), bflo(prw.y), bfhi(prw.y), bflo(prw.z), bfhi(prw.z), bflo(prw.w), bfhi(prw.w)};
          float kp[8] = {bflo(pkw.x), bfhi(pkw.x), bflo(pkw.y), bfhi(pkw.y), bflo(pkw.z), bfhi(pkw.z), bflo(pkw.w), bfhi(pkw.w)};
          float vp[8] = {bflo(pvw.x), bfhi(pvw.x), bflo(pvw.y), bfhi(pvw.y), bflo(pvw.z), bfhi(pvw.z), bflo(pvw.w), bfhi(pvw.w)};
          float av[8] = {bflo(aw.x), bfhi(aw.x), bflo(aw.y), bfhi(aw.y), bflo(aw.z), bfhi(aw.z), bflo(aw.w), bfhi(aw.w)};
          float gt[8] = {bflo(gw_.x), bfhi(gw_.x), bflo(gw_.y), bfhi(gw_.y), bflo(gw_.z), bfhi(gw_.z), bflo(gw_.w), bfhi(gw_.w)};
          float sm = 0.f, bon = 0.f;
#pragma unroll
          for (int e = 0; e < 8; ++e) { sm += y[e];
              const float xr = rc[e] + (rp[e] - rc[e]) * mur[e], xk = kc[e] + (kp[e] - kc[e]) * muk[e]; vc[e] = vc[e] + (vp[e] - vc[e]) * muv[e];
              const float kt = xk * (1.f + (sigm(a0v[e] + av[e]) - 1.f) * ka[e]); bon += xr * kt * rk[e]; }
          sm = allsum8(sm); bon = allsum8(bon);
          const float mean = sm * (1.f / 64.f); float sv = 0.f;
#pragma unroll
          for (int e = 0; e < 8; ++e) { y[e] -= mean; sv += y[e] * y[e]; }
          sv = allsum8(sv); const float rstd = rsqrtf(sv * (1.f / 64.f) + GN_EPS);
#pragma unroll
          for (int e = 0; e < 8; ++e) y[e] = (y[e] * rstd * gw8[e] + gb8[e] + bon * vc[e]) * gt[e];
          v4u w; w.x = pk2(y[0], y[1]); w.y = pk2(y[2], y[3]); w.z = pk2(y[4], y[5]); w.w = pk2(y[6], y[7]);
          *(v4u*)(OY + (size_t)m * D + 512 + rcol) = w; }
    }
}

#define LBAR() do { asm volatile("s_waitcnt lgkmcnt(0)" ::: "memory"); __builtin_amdgcn_s_barrier(); asm volatile("" ::: "memory"); } while (0)
typedef short bf16x8 __attribute__((ext_vector_type(8)));
typedef float f32x2_t __attribute__((ext_vector_type(2)));
typedef __bf16 bf16x2_t __attribute__((ext_vector_type(2)));
__device__ __forceinline__ unsigned cvtpk(float lo, float hi) { const f32x2_t v = {lo, hi}; const bf16x2_t b = __builtin_convertvector(v, bf16x2_t); return __builtin_bit_cast(unsigned, b); }
__device__ __forceinline__ bf16 bf1(float x) { return (bf16)cvtpk(x, 0.f); }
__device__ __forceinline__ float sigm_f(float x) { return __builtin_amdgcn_rcpf(1.f + __expf(-x)); }
__device__ __forceinline__ float silu_f(float x) { return x * sigm_f(x); }
__device__ __forceinline__ float softplus_f(float x) { return fmaxf(x, 0.f) + __logf(1.f + __expf(-fabsf(x))); }

template <bool SWAP, int K> __device__ __forceinline__ f32x4 mm_tile(const LAS bf16* X, int ldx, const LAS bf16* Y, int ldy, int ti, int tj, f32x4 acc, int r, int q) {
    const LAS bf16* xp = X + (16 * ti + r) * ldx + 8 * q; const LAS bf16* yp = Y + (16 * tj + r) * ldy + 8 * q;
#pragma unroll
    for (int k0 = 0; k0 < K; k0 += 32) { const bf16x8 xa = *(const LAS bf16x8*)(xp + k0), yb = *(const LAS bf16x8*)(yp + k0);
        acc = SWAP ? __builtin_amdgcn_mfma_f32_16x16x32_bf16(yb, xa, acc, 0, 0, 0) : __builtin_amdgcn_mfma_f32_16x16x32_bf16(xa, yb, acc, 0, 0, 0); }
    __builtin_amdgcn_sched_barrier(0);
    return acc;
}
__device__ __forceinline__ v2u pk4(f32x4 v) { v2u w; w.x = cvtpk(v[0], v[1]); w.y = cvtpk(v[2], v[3]); return w; }
__device__ __forceinline__ void lt_tile(int lt, int& ti, int& tj) {
    ti = lt < 1 ? 0 : (lt < 3 ? 1 : (lt < 6 ? 2 : 3)); tj = lt - (ti * (ti + 1)) / 2; }
__device__ __forceinline__ void tri_solve(const LAS float* Ap, LAS bf16* Tb, int wave) {
    const int st = wave * 64 + pg8::lane_id_opaque();
    const int s = st & 3, n = st >> 2;
    float tq[16];
#pragma unroll
    for (int jj = 0; jj < 16; ++jj) tq[jj] = 0.f;
    const LAS float* ap = Ap + s * 16;
    const LAS float* apu = Ap; asm volatile("" : "+v"(apu));
    f32x4 a[4][4], an[4][2]; float cc[6], cn[6];
#pragma unroll
    for (int e = 0; e < 4; ++e)
#pragma unroll
        for (int v = 0; v < 4; ++v) { a[e][v] = (f32x4){0.f, 0.f, 0.f, 0.f}; if (v < 2) an[e][v] = a[e][v]; }
    const float f0 = s == 0 ? 1.f : 0.f, f1 = s == 1 ? 1.f : 0.f, f2 = s == 2 ? 1.f : 0.f, f3 = s == 3 ? 1.f : 0.f;
#define TS_LOADC(dst, bb) do { dst[0] = apu[(4 * (bb) + 1) * 68 + (bb)]; dst[1] = apu[(4 * (bb) + 2) * 68 + (bb)]; dst[2] = apu[(4 * (bb) + 2) * 68 + 16 + (bb)]; \
        dst[3] = apu[(4 * (bb) + 3) * 68 + (bb)]; dst[4] = apu[(4 * (bb) + 3) * 68 + 16 + (bb)]; dst[5] = apu[(4 * (bb) + 3) * 68 + 32 + (bb)]; } while (0)
    TS_LOADC(cc, 0);
#pragma unroll
    for (int b = 0; b < 16; ++b) {
#pragma unroll
        for (int e = 0; e < 4; ++e)
#pragma unroll
            for (int v = 2; v < 4; ++v) if (4 * v < b) a[e][v] = *(const LAS f32x4*)(ap + (4 * b + e) * 68 + 4 * v);
        if (b + 1 < 16) {
#pragma unroll
            for (int e = 0; e < 4; ++e)
#pragma unroll
                for (int v = 0; v < 2; ++v) if (4 * v < b + 1) an[e][v] = *(const LAS f32x4*)(ap + (4 * (b + 1) + e) * 68 + 4 * v);
            TS_LOADC(cn, b + 1);
        }
        float p[4] = {0.f, 0.f, 0.f, 0.f};
#pragma unroll
        for (int jj = 0; jj < 16; ++jj) if (jj < b) {
#pragma unroll
            for (int e = 0; e < 4; ++e) p[e] += a[e][jj >> 2][jj & 3] * tq[jj]; }
#pragma unroll
        for (int e = 0; e < 4; ++e) p[e] = allsum4(p[e]);
        const float t0 = p[0] + (n == 4 * b ? 1.f : 0.f);
        const float t1 = p[1] + cc[0] * t0 + (n == 4 * b + 1 ? 1.f : 0.f);
        const float t2 = p[2] + cc[1] * t0 + cc[2] * t1 + (n == 4 * b + 2 ? 1.f : 0.f);
        const float t3 = p[3] + cc[3] * t0 + cc[4] * t1 + cc[5] * t2 + (n == 4 * b + 3 ? 1.f : 0.f);
        tq[b] = (f0 * t0 + f1 * t1) + (f2 * t2 + f3 * t3);
        asm volatile("" ::: "memory");
#pragma unroll
        for (int e = 0; e < 4; ++e)
#pragma unroll
            for (int v = 0; v < 2; ++v) a[e][v] = an[e][v];
#pragma unroll
        for (int k = 0; k < 6; ++k) cc[k] = cn[k];
    }
#undef TS_LOADC
#pragma unroll
    for (int jj = 0; jj < 16; ++jj) Tb[(4 * jj + s) * 72 + n] = bf1(tq[jj]);
}

__device__ __forceinline__ void rwkv_chunk_unit(Frame& F, int unit) {
    const int b = unit >> 4, h = (unit >> 1) & 7, hf = unit & 1, tid = F.tid, lane = F.lane, wave = F.wave;
    LAS bf16* AT = (LAS bf16*)F.lds; LAS bf16* BT = AT + 4608; LAS bf16* KT = BT + 4608; LAS bf16* QT = KT + 4608;
    LAS bf16* BDt = QT + 4608; LAS bf16* KDt = BDt + 4608; LAS bf16* Vt = KDt + 4608;
    LAS bf16* Aak = Vt + 4608; LAS bf16* Aqb = Aak + 4608; LAS bf16* Aqk = Aqb + 4608; LAS bf16* Tb = Aqk + 4608; LAS bf16* Ht = Tb + 4608;
    LAS float* Ap = (LAS float*)(Ht + 4608); LAS float* GT = Ap + 64 * 68; LAS float* GL = GT + 512;
    LAS bf16* Rt = BT; LAS bf16* Ut = AT;
    const bf16* proj = (const bf16*)(F.ws + WS_PROJ); const bf16* LO = (const bf16*)(F.ws + WS_LO); bf16* OY = (bf16*)(F.ws + WS_XN);
    const float* mu = F.in[13];
    const int c = lane, ig = wave, cr = h * 64 + c;
    const float mu_r = mu[cr], mu_k = mu[512 + cr], mu_v = mu[1024 + cr], kkw = F.in[19][cr], kaw = F.in[20][cr], w0c = F.in[14][cr], a0c = F.in[16][cr];
    for (int i = tid; i < 4608 / 2; i += NTHREADS) { ((LAS unsigned*)Ht)[i] = 0u; ((LAS unsigned*)Aak)[i] = 0u; ((LAS unsigned*)Aqb)[i] = 0u; ((LAS unsigned*)Aqk)[i] = 0u; }
    f32x4 hacc[2], yacc[2];
#pragma unroll
    for (int u = 0; u < 2; ++u) hacc[u] = (f32x4){0.f, 0.f, 0.f, 0.f};
    bf16 rr[9], rk[9], rv[9], lw[8], la[8];
#define RWKV_LOAD(chn) do { const size_t mq = (size_t)b * SEQ + (chn) * 64 + ig * 8; const bf16* pq = proj + (mq - 1) * PC + RW0 + cr; const bf16* pl = LO + mq * LOC + cr;     \
        _Pragma("unroll") for (int ii = 0; ii < 9; ++ii) { rr[ii] = pq[0]; rk[ii] = pq[512]; rv[ii] = pq[1024]; pq += PC; asm volatile("" : "+v"(pq)); } \
        _Pragma("unroll") for (int ii = 0; ii < 8; ++ii) { lw[ii] = pl[0]; la[ii] = pl[512]; pl += LOC; asm volatile("" : "+v"(pl)); } } while (0)
    __syncthreads();
    for (int ch = 0; ch < SEQ / 64; ++ch) {
        const int t0 = ch * 64; const size_t m0 = (size_t)b * SEQ + t0;
        const int lq = pg8::lane_id_opaque(), r = lq & 15, q = lq >> 4;
        float xr[8], kt[8], xv[8], kkn[8], bb[8], ldv[8], lc[8];
        RWKV_LOAD(ch);
        {
            float run = 0.f;
#pragma unroll
            for (int ii = 0; ii < 8; ++ii) {
                const float r1 = bf2f(rr[ii + 1]), k1 = bf2f(rk[ii + 1]), v1 = bf2f(rv[ii + 1]);
                const bool z0 = (ii == 0 && t0 + ig * 8 == 0);
                xr[ii] = r1 + ((z0 ? 0.f : bf2f(rr[ii])) - r1) * mu_r; const float xk = k1 + ((z0 ? 0.f : bf2f(rk[ii])) - k1) * mu_k; xv[ii] = v1 + ((z0 ? 0.f : bf2f(rv[ii])) - v1) * mu_v;
                const float zw = w0c + bf2f(lw[ii]), a = sigm_f(a0c + bf2f(la[ii]));
                ldv[ii] = -__expf(-softplus_f(-zw) - 0.5f);
                const float kv = xk * kkw; const float ss = wave_sum(kv * kv); kkn[ii] = kv * rsqrtf(ss + L2_EPS);
                kt[ii] = xk * (1.f + (a - 1.f) * kaw); bb[ii] = kkn[ii] * a;
                run += ldv[ii]; lc[ii] = run; }
            GT[ig * 64 + c] = run;
        }
        LBAR();
        {
            float off = 0.f, tot = 0.f;
#pragma unroll
            for (int g = 0; g < 8; ++g) { const float gv = GT[g * 64 + c]; tot += gv; off += (g < ig) ? gv : 0.f; }
            const int i0 = ig * 8;
            float bd[8], kd[8];
            const float etot = __expf(tot); float egp = __expf(off);
#pragma unroll
            for (int ii = 0; ii < 8; ++ii) { const float gc = off + lc[ii]; const float eg = __expf(gc), ieg = __builtin_amdgcn_rcpf(eg), ed = etot * ieg;
                AT[(i0 + ii) * 72 + c] = bf1(-kkn[ii] * egp); egp = eg; BT[(i0 + ii) * 72 + c] = bf1(bb[ii] * ieg);
                KT[(i0 + ii) * 72 + c] = bf1(kt[ii] * ieg); QT[(i0 + ii) * 72 + c] = bf1(xr[ii] * eg);
                bd[ii] = bb[ii] * ed; kd[ii] = kt[ii] * ed; }
            v4u w;
            w.x = cvtpk(bd[0], bd[1]); w.y = cvtpk(bd[2], bd[3]); w.z = cvtpk(bd[4], bd[5]); w.w = cvtpk(bd[6], bd[7]); *(LAS v4u*)(BDt + c * 72 + i0) = w;
            w.x = cvtpk(kd[0], kd[1]); w.y = cvtpk(kd[2], kd[3]); w.z = cvtpk(kd[4], kd[5]); w.w = cvtpk(kd[6], kd[7]); *(LAS v4u*)(KDt + c * 72 + i0) = w;
            w.x = cvtpk(xv[0], xv[1]); w.y = cvtpk(xv[2], xv[3]); w.z = cvtpk(xv[4], xv[5]); w.w = cvtpk(xv[6], xv[7]); if ((c >> 5) == hf) *(LAS v4u*)(Vt + (c & 31) * 72 + i0) = w;
            if (ig == 0) GL[c] = etot;
        }
        LBAR();
#pragma unroll
        for (int nn = 0; nn < 5; ++nn) { const int jb = wave + 8 * nn, p = jb / 10; int ti, tj; lt_tile(jb % 10, ti, tj);
            const LAS bf16* X = (p < 2) ? AT : QT; const LAS bf16* Y = (p == 0 || p == 2) ? BT : KT;
            f32x4 acc = mm_tile<true, 64>(X, 72, Y, 72, ti, tj, (f32x4){0.f, 0.f, 0.f, 0.f}, r, q);
            const int i = 16 * ti + r, j0 = 16 * tj + 4 * q;
#pragma unroll
            for (int e = 0; e < 4; ++e) { const bool keep = (p < 2) ? (j0 + e < i) : (j0 + e <= i); acc[e] = keep ? acc[e] : 0.f; }
            if (p == 0) {
#pragma unroll
                for (int e = 0; e < 4; ++e) Ap[i * 68 + e * 16 + 4 * tj + q] = acc[e];
            } else { LAS bf16* O = (p == 1) ? Aak : (p == 2 ? Aqb : Aqk); *(LAS v2u*)(O + i * 72 + j0) = pk4(acc); } }
        LBAR();
        {
            const int chn = ch + 1 < SEQ / 64 ? ch + 1 : ch, trow = lq >> 3, tl = (lq & 7) < 5 ? (lq & 7) : 4; const size_t mrow = (size_t)b * SEQ + chn * 64 + ig * 8 + trow;
            const bf16* src = tl < 3 ? proj + mrow * PC + RW0 + h * 64 + tl * 512 : LO + mrow * LOC + h * 64 + (tl - 3) * 512;
            __builtin_amdgcn_global_load_lds((const unsigned*)src, (LAS unsigned*)(F.lds + 130560 + wave * 256), 4, 0, 0); }
        if (wave < 4) tri_solve(Ap, Tb, wave);
        else { const int wv = wave - 4; f32x4 racc[2];
#pragma unroll
            for (int u = 0; u < 2; ++u) { const int t = wv * 2 + u, ti = t >> 1, tj = t & 1;
                f32x4 ra = mm_tile<false, 64>(Aak, 72, Vt, 72, ti, tj, (f32x4){0.f, 0.f, 0.f, 0.f}, r, q); racc[u] = mm_tile<false, 64>(AT, 72, Ht, 72, ti, tj, ra, r, q);
                f32x4 ya = mm_tile<true, 64>(QT, 72, Ht, 72, ti, tj, (f32x4){0.f, 0.f, 0.f, 0.f}, r, q); yacc[u] = mm_tile<true, 64>(Aqk, 72, Vt, 72, ti, tj, ya, r, q);
                const f32x4 gl = *(const LAS f32x4*)(GL + 16 * ti + 4 * q);
                hacc[u] = mm_tile<false, 64>(KDt, 72, Vt, 72, ti, tj, hacc[u] * gl, r, q); }
#pragma unroll
            for (int u = 0; u < 2; ++u) { const int t = wv * 2 + u, ti = t >> 1, tj = t & 1; *(LAS v2u*)(Rt + (16 * tj + r) * 72 + 16 * ti + 4 * q) = pk4(racc[u]); } }
        LBAR();
        { const int t = wave, ti = t >> 1, tj = t & 1;
            const f32x4 ua = mm_tile<false, 64>(Tb, 72, Rt, 72, ti, tj, (f32x4){0.f, 0.f, 0.f, 0.f}, r, q);
            *(LAS v2u*)(Ut + (16 * tj + r) * 72 + 16 * ti + 4 * q) = pk4(ua); }
        LBAR();
        if (wave >= 4) { const int wv = wave - 4;
#pragma unroll
            for (int u = 0; u < 2; ++u) { const int t = wv * 2 + u, ti = t >> 1, tj = t & 1;
                yacc[u] = mm_tile<true, 64>(Aqb, 72, Ut, 72, ti, tj, yacc[u], r, q);
                hacc[u] = mm_tile<false, 64>(BDt, 72, Ut, 72, ti, tj, hacc[u], r, q); }
#pragma unroll
            for (int u = 0; u < 2; ++u) { const int t = wv * 2 + u, ti = t >> 1, tj = t & 1;
                *(v2u*)(OY + (m0 + 16 * ti + r) * D + 512 + h * 64 + hf * 32 + 16 * tj + 4 * q) = pk4(yacc[u]);
                *(LAS v2u*)(Ht + (16 * tj + r) * 72 + 16 * ti + 4 * q) = pk4(hacc[u]); } }
        LBAR();
    }
}

__device__ __forceinline__ void gdn_chunk_unit(Frame& F, int unit) {
    const int b = unit >> 4, h = (unit >> 2) & 3, sl = unit & 3, tid = F.tid, lane = F.lane, wave = F.wave;
    LAS bf16* QH = (LAS bf16*)F.lds; LAS bf16* KH = QH + 64 * 136; LAS bf16* KHt = KH + 64 * 136;
    LAS bf16* Aqk = KHt + 128 * 72; LAS bf16* Tb = Aqk + 4608; LAS bf16* Rt = Tb + 4608; LAS bf16* VNt = Rt + 32 * 72; LAS bf16* VNSt = VNt + 32 * 72;
    LAS bf16* St = VNSt + 32 * 72;
    LAS float* V32 = (LAS float*)(St + 32 * 136); LAS float* Ap = V32 + 64 * 32; LAS float* PS = Ap + 64 * 68;
    LAS float* GV = PS + 1024; LAS float* GC = GV + 64; LAS float* EGQ = GC + 64; LAS float* BE = EGQ + 64; LAS float* BEGK = BE + 64; LAS float* DLK = BEGK + 64; LAS float* SQ = DLK + 64; LAS float* SK = SQ + 64; LAS float* GLS = SK + 64;
    const bf16* proj = (const bf16*)(F.ws + WS_PROJ); const float* bg = (const float*)(F.ws + WS_BG); bf16* OY = (bf16*)(F.ws + WS_XN);
    const float* cw = F.in[9];
    const int cp = tid & 127, qt = tid >> 7, isk = cp >> 6, cq = (cp & 63) * 2, pcol = isk ? (512 + h * 128 + cq) : (h * 128 + cq);

    const int vd = tid & 31, vg = tid >> 5, vcol = 1024 + h * 128 + sl * 32 + vd;
    const float Ah = -expf(F.in[10][h]), dtb = F.in[11][h];
    for (int i = tid; i < 32 * 136 / 2; i += NTHREADS) ((LAS unsigned*)St)[i] = 0u;
    for (int i = tid; i < 4608 / 2; i += NTHREADS) ((LAS unsigned*)Aqk)[i] = 0u;
    f32x4 sacc[4], oacc[2];
#pragma unroll
    for (int u = 0; u < 4; ++u) sacc[u] = (f32x4){0.f, 0.f, 0.f, 0.f};
    unsigned xq[19]; bf16 xv_[7]; float bgb = 0.f, bga = 0.f;
#define GDN_LOAD(chn) do { const size_t mq = (size_t)b * SEQ + (chn) * 64 + qt * 16; const bf16* pq = proj + (mq - 3) * PC + pcol;     \
        _Pragma("unroll") for (int ii = 0; ii < 19; ++ii) { xq[ii] = *(const unsigned*)pq; pq += PC; asm volatile("" : "+v"(pq)); } \
        const size_t mv = (size_t)b * SEQ + (chn) * 64 + vg * 4; const bf16* pv = proj + (mv - 3) * PC + vcol; \
        _Pragma("unroll") for (int ii = 0; ii < 7; ++ii) { xv_[ii] = *pv; pv += PC; asm volatile("" : "+v"(pv)); } \
        if (tid < 64) { bgb = bg[((size_t)b * SEQ + (chn) * 64 + tid) * 8 + h]; bga = bg[((size_t)b * SEQ + (chn) * 64 + tid) * 8 + 4 + h]; } } while (0)
    __syncthreads();
    for (int ch = 0; ch < SEQ / 64; ++ch) {
        const int t0 = ch * 64; const size_t m0 = (size_t)b * SEQ + t0;
        const int lq = pg8::lane_id_opaque(), r = lq & 15, q = lq >> 4;
        GDN_LOAD(ch);
        const float cw0 = cw[pcol], cw1 = cw[1536 + pcol], cw2 = cw[2 * 1536 + pcol], cw3 = cw[3 * 1536 + pcol];
        const float dw0 = cw[pcol + 1], dw1 = cw[1536 + pcol + 1], dw2 = cw[2 * 1536 + pcol + 1], dw3 = cw[3 * 1536 + pcol + 1];
        const float vw0 = cw[vcol], vw1 = cw[1536 + vcol], vw2 = cw[2 * 1536 + vcol], vw3 = cw[3 * 1536 + vcol];
        {
            const int i0 = qt * 16; LAS bf16* dst = isk ? KH : QH;
            if (t0 + i0 == 0) { xq[0] = 0u; xq[1] = 0u; xq[2] = 0u; }
            float psa = 0.f;
#pragma unroll
            for (int g = 0; g < 2; ++g) { float a8[8], b8[8];
#pragma unroll
                for (int e = 0; e < 8; ++e) { const int ii = 8 * g + e;
                    a8[e] = silu_f(cw0 * bflo(xq[ii]) + cw1 * bflo(xq[ii + 1]) + cw2 * bflo(xq[ii + 2]) + cw3 * bflo(xq[ii + 3]));
                    b8[e] = silu_f(dw0 * bfhi(xq[ii]) + dw1 * bfhi(xq[ii + 1]) + dw2 * bfhi(xq[ii + 2]) + dw3 * bfhi(xq[ii + 3]));
                    const float ps = allsum16(a8[e] * a8[e] + b8[e] * b8[e]);
                    psa = (r == ii) ? ps : psa;
                    *(LAS unsigned*)(dst + (i0 + ii) * 136 + cq) = cvtpk(a8[e], b8[e]); }
                if (isk) { v4u w; w.x = cvtpk(a8[0], a8[1]); w.y = cvtpk(a8[2], a8[3]); w.z = cvtpk(a8[4], a8[5]); w.w = cvtpk(a8[6], a8[7]); *(LAS v4u*)(KHt + cq * 72 + i0 + 8 * g) = w;
                    w.x = cvtpk(b8[0], b8[1]); w.y = cvtpk(b8[2], b8[3]); w.z = cvtpk(b8[4], b8[5]); w.w = cvtpk(b8[6], b8[7]); *(LAS v4u*)(KHt + (cq + 1) * 72 + i0 + 8 * g) = w; } }
            PS[(isk * 4 + q) * 64 + i0 + r] = psa;
        }
        {
            const int i0 = vg * 4;
            float xm3 = bf2f(xv_[0]), xm2 = bf2f(xv_[1]), xm1 = bf2f(xv_[2]); if (t0 + i0 == 0) { xm3 = 0.f; xm2 = 0.f; xm1 = 0.f; }
#pragma unroll
            for (int ii = 0; ii < 4; ++ii) { const float x0 = bf2f(xv_[3 + ii]); V32[(i0 + ii) * 32 + vd] = silu_f(vw0 * xm3 + vw1 * xm2 + vw2 * xm1 + vw3 * x0); xm3 = xm2; xm2 = xm1; xm1 = x0; }
        }
        if (tid < 64) { BE[tid] = sigm_f(bgb); GV[tid] = Ah * softplus_f(bga + dtb); }
        LBAR();
        if (tid < 64) {
            float pre = GV[tid];
            pre += dpp_f<0x111>(pre); pre += dpp_f<0x112>(pre); pre += dpp_f<0x114>(pre); pre += dpp_f<0x118>(pre);
            const int ip = __builtin_bit_cast(int, pre);
            const float t0r = __builtin_bit_cast(float, __builtin_amdgcn_readlane(ip, 15)), t1r = __builtin_bit_cast(float, __builtin_amdgcn_readlane(ip, 31)), t2r = __builtin_bit_cast(float, __builtin_amdgcn_readlane(ip, 47)), t3r = __builtin_bit_cast(float, __builtin_amdgcn_readlane(ip, 63));
            pre += (q >= 1 ? t0r : 0.f) + (q >= 2 ? t1r : 0.f) + (q >= 3 ? t2r : 0.f);
            const float tot = (t0r + t1r) + (t2r + t3r);
            float s0 = 0.f, s1 = 0.f;
#pragma unroll
            for (int p = 0; p < 4; ++p) { s0 += PS[p * 64 + tid]; s1 += PS[(4 + p) * 64 + tid]; }
            const float eg = __expf(pre), sq = rsqrtf(s0 + L2_EPS) * 0.08838834764831845f, sk = rsqrtf(s1 + L2_EPS);
            GC[tid] = pre; SQ[tid] = sq; SK[tid] = sk; EGQ[tid] = eg * sq; BEGK[tid] = BE[tid] * eg * sk; DLK[tid] = __expf(tot - pre) * sk; if (tid == 0) GLS[0] = __expf(tot);
        }
        LBAR();
#pragma unroll
        for (int nn = 0; nn < 3; ++nn) { const int jb = wave + 8 * nn;
            if (jb < 20) { const int p = jb / 10; int ti, tj; lt_tile(jb % 10, ti, tj);
                f32x4 acc = mm_tile<true, 128>(p ? QH : KH, 136, KH, 136, ti, tj, (f32x4){0.f, 0.f, 0.f, 0.f}, r, q);
                const int i = 16 * ti + r, j0 = 16 * tj + 4 * q; const float gi = GC[i]; const f32x4 gj = *(const LAS f32x4*)(GC + j0);
                const f32x4 skj = *(const LAS f32x4*)(SK + j0);
                if (p == 0) { const float nb = -BE[i] * SK[i];
#pragma unroll
                    for (int e = 0; e < 4; ++e) Ap[i * 68 + e * 16 + 4 * tj + q] = (j0 + e < i) ? nb * skj[e] * acc[e] * __expf(gi - gj[e]) : 0.f;
                } else { const float sqi = SQ[i];
#pragma unroll
                    for (int e = 0; e < 4; ++e) acc[e] = (j0 + e <= i) ? sqi * skj[e] * acc[e] * __expf(gi - gj[e]) : 0.f;
                    *(LAS v2u*)(Aqk + i * 72 + j0) = pk4(acc); } } }
        LBAR();
        {
            const int chn = ch + 1 < SEQ / 64 ? ch + 1 : ch; const size_t mb = (size_t)b * SEQ + chn * 64;
            { const int L = lq < 38 ? lq : 37; const bf16* src = proj + (mb + qt * 16 - 3 + (L >> 1)) * PC + (isk ? 512 : 0) + h * 128 + (L & 1) * 64;
              __builtin_amdgcn_global_load_lds((const unsigned*)src, (LAS unsigned*)(F.lds + 126464 + wave * 256), 4, 0, 0); }
            { const size_t row = mb + wave * 8 + (lq & 7); const void* src = (lq >> 3) == 0 ? (const void*)(proj + row * PC + 1024 + h * 128 + sl * 32) : (const void*)(bg + row * 8);
              __builtin_amdgcn_global_load_lds((const unsigned*)src, (LAS unsigned*)(F.lds + 126464 + wave * 256), 4, 0, 0); } }
        if (wave < 4) tri_solve(Ap, Tb, wave);
        else { const int wv = wave - 4;
#pragma unroll
            for (int u = 0; u < 2; ++u) { const int t = wv * 2 + u, ti = t >> 1, tj = t & 1;
                const f32x4 ks = mm_tile<false, 128>(KH, 136, St, 136, ti, tj, (f32x4){0.f, 0.f, 0.f, 0.f}, r, q);
                f32x4 rv;
#pragma unroll
                for (int e = 0; e < 4; ++e) { const int i = 16 * ti + 4 * q + e; rv[e] = BE[i] * V32[i * 32 + 16 * tj + r] - BEGK[i] * ks[e]; }
                *(LAS v2u*)(Rt + (16 * tj + r) * 72 + 16 * ti + 4 * q) = pk4(rv);
                oacc[u] = mm_tile<true, 128>(QH, 136, St, 136, ti, tj, (f32x4){0.f, 0.f, 0.f, 0.f}, r, q) * EGQ[16 * ti + r]; } }
        LBAR();
        if (wave >= 4) { const int wv = wave - 4;
#pragma unroll
            for (int u = 0; u < 2; ++u) { const int t = wv * 2 + u, ti = t >> 1, tj = t & 1;
                const f32x4 vn = mm_tile<false, 64>(Tb, 72, Rt, 72, ti, tj, (f32x4){0.f, 0.f, 0.f, 0.f}, r, q);
                const f32x4 dl = *(const LAS f32x4*)(DLK + 16 * ti + 4 * q);
                *(LAS v2u*)(VNt + (16 * tj + r) * 72 + 16 * ti + 4 * q) = pk4(vn); *(LAS v2u*)(VNSt + (16 * tj + r) * 72 + 16 * ti + 4 * q) = pk4(vn * dl); } }
        LBAR();
        if (wave >= 4) { const int wv = wave - 4; const float gls = GLS[0];
#pragma unroll
            for (int u = 0; u < 2; ++u) { const int t = wv * 2 + u, ti = t >> 1, tj = t & 1;
                const f32x4 o = mm_tile<true, 64>(Aqk, 72, VNt, 72, ti, tj, oacc[u], r, q);
                *(v2u*)(OY + (m0 + 16 * ti + r) * D + h * 128 + sl * 32 + 16 * tj + 4 * q) = pk4(o); }
#pragma unroll
            for (int u = 0; u < 4; ++u) { const int t = wv * 4 + u, ti = t >> 1, tj = t & 1;
                sacc[u] = mm_tile<false, 64>(KHt, 72, VNSt, 72, ti, tj, sacc[u] * gls, r, q);
                *(LAS v2u*)(St + (16 * tj + r) * 136 + 16 * ti + 4 * q) = pk4(sacc[u]); } }
        LBAR();
    }
}

#define XB_TMO      128
#define XB_XCNT(j)  (256  + 64 * (j))
#define XB_XSUB(j)  (1280 + 64 * (j))
#define XB_XGEN(j)  (2304 + 64 * (j))
#define XB_TOP      3328
#define XB_TOPGEN   3392
#define XCD_BAR_WORDS 3456
#define XB_SPIN_CAP (1u << 18)

__device__ __forceinline__ unsigned xb_ld(unsigned* p)              { return __hip_atomic_load(p, __ATOMIC_RELAXED, __HIP_MEMORY_SCOPE_AGENT); }
__device__ __forceinline__ unsigned xb_add(unsigned* p, unsigned v) { return __hip_atomic_fetch_add(p, v, __ATOMIC_RELAXED, __HIP_MEMORY_SCOPE_AGENT); }
__device__ __forceinline__ unsigned xb_xcc_id() { return (unsigned)__builtin_amdgcn_s_getreg((3 << 11) | 20) & 0xFu; }
#define XB_SPIN(cond, bar) do { unsigned _sp = 0; while (cond) { __builtin_amdgcn_s_sleep(1); \
    if ((++_sp & 255u) == 0u) { if (xb_ld(&(bar)[XB_TMO])) break; if (_sp > XB_SPIN_CAP) { atomicAdd(&(bar)[XB_TMO], 1u); break; } } } } while (0)

struct XcdBarrier {
    unsigned* bar; unsigned x;
    volatile LAS unsigned* st;
};

__device__ __forceinline__ XcdBarrier xcd_barrier_post(unsigned* bar, volatile LAS unsigned* st) {
    XcdBarrier b; b.bar = bar; b.x = xb_xcc_id(); b.st = st;
    if (threadIdx.x == 0) (void)xb_add(&bar[XB_XCNT(b.x)], 1u);
    return b;
}
__device__ __forceinline__ void xcd_barrier_complete(unsigned* bar, unsigned x, unsigned& nloc, unsigned& nx) {
    const unsigned G = gridDim.x * gridDim.y * gridDim.z;
    unsigned sum, cnt, mine, sp = 0u;
    for (;;) {
        sum = 0u; cnt = 0u; mine = 0u;
#pragma unroll
        for (unsigned j = 0; j < 16; ++j) { const unsigned c = xb_ld(&bar[XB_XCNT(j)]); sum += c; cnt += (c > 0u) ? 1u : 0u; mine = (j == x) ? c : mine; }
        if (sum == G) break;
        __builtin_amdgcn_s_sleep(1);
        if ((++sp & 255u) == 0u) { if (xb_ld(&bar[XB_TMO])) break; if (sp > XB_SPIN_CAP) { atomicAdd(&bar[XB_TMO], 1u); break; } }
    }
    nloc = mine > 0u ? mine : 1u; nx = cnt > 0u ? cnt : 1u;
}

__device__ __forceinline__ void xcd_barrier(const XcdBarrier& b) {
    asm volatile("s_waitcnt vmcnt(0)" ::: "memory");
    __syncthreads();
    if (threadIdx.x == 0) {
        unsigned* bar = b.bar;
        __builtin_amdgcn_s_waitcnt(0);
        unsigned nloc = b.st[0], nx = b.st[1];
        if (nloc == 0u) { xcd_barrier_complete(bar, b.x, nloc, nx); b.st[0] = nloc; b.st[1] = nx; }
        const unsigned old = xb_add(&bar[XB_XSUB(b.x)], 1u);
        const unsigned gen = old / nloc;
        if (old + 1u == (gen + 1u) * nloc) {
            __builtin_amdgcn_fence(__ATOMIC_RELEASE, "agent");
            asm volatile("s_waitcnt vmcnt(0)" ::: "memory");
            const unsigned og = xb_add(&bar[XB_TOP], 1u);
            const unsigned tg = og / nx;
            if (og + 1u == (tg + 1u) * nx) xb_add(&bar[XB_TOPGEN], 1u);
            else XB_SPIN(xb_ld(&bar[XB_TOPGEN]) == tg, bar);
            __builtin_amdgcn_fence(__ATOMIC_ACQUIRE, "agent");
            xb_add(&bar[XB_XGEN(b.x)], 1u);
            asm volatile("s_waitcnt vmcnt(0)" ::: "memory");
        } else {
            XB_SPIN(xb_ld(&bar[XB_XGEN(b.x)]) == gen, bar);
            __builtin_amdgcn_fence(__ATOMIC_ACQUIRE, "agent");
            asm volatile("s_waitcnt vmcnt(0)" ::: "memory");
        }
    }
    __syncthreads();
}

__device__ __forceinline__ void gbar_counter(unsigned* cnt, unsigned target, int tid) {
    asm volatile("s_waitcnt vmcnt(0)" ::: "memory");
    __syncthreads();
    if (tid == 0) {
        __builtin_amdgcn_fence(__ATOMIC_RELEASE, "agent");
        asm volatile("s_waitcnt vmcnt(0)" ::: "memory");
        __hip_atomic_fetch_add(cnt, 1u, __ATOMIC_RELAXED, __HIP_MEMORY_SCOPE_AGENT);
        while (__hip_atomic_load(cnt, __ATOMIC_RELAXED, __HIP_MEMORY_SCOPE_AGENT) < target) __builtin_amdgcn_s_sleep(2);
        __builtin_amdgcn_fence(__ATOMIC_ACQUIRE, "agent");
        asm volatile("s_waitcnt vmcnt(0)" ::: "memory");
    }
    __syncthreads();
}

__global__ void __launch_bounds__(NTHREADS, 2) mega_fwd(Args args) {
    extern __shared__ __attribute__((aligned(16))) unsigned char lds[];
    cg::grid_group grid = cg::this_grid();
    Frame F;
    F.lds = (LAS unsigned char*)lds; F.wave = __builtin_amdgcn_readfirstlane((int)threadIdx.x >> 6); F.G = gridDim.x;
#define REFRESH() do { F.lane = pg8::lane_id_opaque(); F.tid = F.wave * 64 + F.lane; } while (0)
    REFRESH();
    F.in = args.in; F.out = args.out; F.ws = args.ws;
    unsigned char* ws = args.ws;
    bf16* XN = (bf16*)(ws + WS_XN); bf16* H = (bf16*)(ws + WS_H); bf16* Fm = (bf16*)(ws + WS_F); bf16* PROJ = (bf16*)(ws + WS_PROJ); bf16* Tm = (bf16*)(ws + WS_T);
    bf16* LO = (bf16*)(ws + WS_LO); bf16* LA = (bf16*)(ws + WS_LA); float* BG = (float*)(ws + WS_BG);
    const int bx = (int)blockIdx.x;
    bf16* XB = (bf16*)F.out;
    bf16* XB3 = (bf16*)(ws + WS_XB3);
    unsigned* barw = (unsigned*)(ws + WS_BAR);
    volatile LAS unsigned* MISC = (volatile LAS unsigned*)(F.lds + 147200);
    if (F.tid < 32) MISC[F.tid] = 0u;
    if (bx == 0) for (int i = F.tid; i < XCD_BAR_WORDS; i += NTHREADS) barw[i] = 0u;
    __syncthreads();
    XcdBarrier xbar; xbar.bar = barw; xbar.x = 0; xbar.st = MISC + 8;
    bool xb_ready = false;

#ifndef PROBE_MASK
#define PROBE_MASK 0
#endif
#ifdef TS_PROBE
#define TSX(k, blk) do { if (bx == (blk) && F.tid == 0) ((unsigned long long*)(ws + WS_BG + 2 * MiB))[k] = __builtin_amdgcn_s_memrealtime(); } while (0)
#define STAMP(k) do { if (bx == 0 && F.tid == 0) ((unsigned long long*)(ws + WS_BG + 2 * MiB))[k] = __builtin_amdgcn_s_memrealtime(); } while (0)
#else
#define TSX(k, blk) do { } while (0)
#define STAMP(k) do { } while (0)
#endif
#define RUN(k, ...) for (int rep_ = 0; rep_ < (((PROBE_MASK) >> (k)) & 1) + 1; ++rep_) { __VA_ARGS__; if (!xb_ready) { grid.sync(); xbar = xcd_barrier_post(barw, MISC + 8); xb_ready = true; } else xcd_barrier(xbar); REFRESH(); STAMP((k) + 1); }
    STAMP(0);
    RUN(0, p0_prologue(F))
    RUN(1, { pg8::Gemm g{XN, (const bf16*)(ws + WS_WGU1), M, 2 * DFF, D, D}; pg8::StaticOrder S; S.init(M, 2 * DFF, F.G, bx); pg8::EpiSwiglu E{H, HLD};
      pg8::gemm_phase<pg8::EpiSwiglu, pg8::StaticOrder, true, true>(F.lds, g, S, E, F.wave); })
    RUN(2, { pg8::Gemm g{H, (const bf16*)(ws + WS_WD1), M, D, DFF, HLD}; pg8::StaticOrder S; S.init(M, D, F.G, bx); S.rev = 1; pg8::EpiBf16<0> E{Fm, D, nullptr, 0, 0, 1.f};
      pg8::gemm_phase<pg8::EpiBf16<0>, pg8::StaticOrder, true, true>(F.lds, g, S, E, F.wave); })
    RUN(3, row_phase<true, true, false, true>(F, Fm, F.in[0], XB, 0.5f, F.in[6], F.in[7], XN, F.in[8], BG))
    RUN(4, { pg8::Gemm g{XN, (const bf16*)(ws + WS_WIN), M, PC, D, D}; pg8::StaticOrder S; S.init(M, PC, F.G, bx); pg8::EpiBf16<0> E{PROJ, PC, nullptr, 0, 0, 1.f};
      pg8::gemm_phase<pg8::EpiBf16<0>, pg8::StaticOrder, true, true>(F.lds, g, S, E, F.wave); })
    RUN(5, lora_in_phase(F))
    RUN(6, { pg8::Gemm g{LA, (const bf16*)(ws + WS_WL), M, LOC, 256, 256}; pg8::StaticOrder S; S.init(M, LOC, F.G, bx); pg8::EpiBf16<0> E{LO, LOC, nullptr, 0, 0, 1.f};
      pg8::gemm_phase<pg8::EpiBf16<0>, pg8::StaticOrder, true, true>(F.lds, g, S, E, F.wave); })
    RUN(7, { const bool xa = (F.G == 256);
        for (int u = bx; u < 128; u += F.G) { const int xc = u & 7, kk_ = u >> 3; gdn_chunk_unit(F, xa ? (((xc * 4 + (kk_ >> 2)) << 2) | (kk_ & 3)) : u); } REFRESH(); TSX(20, 0);
        for (int u = bx; u < 256; u += F.G) if (u >= 128) { const int j_ = u - 128, xc = j_ & 7, kk_ = j_ >> 3; rwkv_chunk_unit(F, xa ? (((xc * 8 + (kk_ >> 1)) << 1) | (kk_ & 1)) : j_); } REFRESH(); TSX(21, 128);
        late_prologue(F, 0, xa ? 128 : F.G); })
    RUN(8, mixer_post_phase(F))
    RUN(9, { pg8::Gemm g{XN, (const bf16*)(ws + WS_WOUT), M, D, D, D}; pg8::StaticOrder S; S.init(M, D, F.G, bx); pg8::EpiBf16<0> E{Fm, D, nullptr, 0, 0, 1.f};
      pg8::gemm_phase<pg8::EpiBf16<0>, pg8::StaticOrder, true, true>(F.lds, g, S, E, F.wave); })
    RUN(10, { row_phase<true, false, true, true>(F, Fm, XB, XB, 1.0f, F.in[25], F.in[26], XN, nullptr, nullptr);
})
    RUN(11, { pg8::Gemm g{XN, (const bf16*)(ws + WS_WGU2), M, 2 * DFF, D, D}; pg8::StaticOrder S; S.init(M, 2 * DFF, F.G, bx); pg8::EpiSwiglu E{H, HLD};
      pg8::gemm_phase<pg8::EpiSwiglu, pg8::StaticOrder, true, true>(F.lds, g, S, E, F.wave); })
    RUN(12, { pg8::Gemm g{H, (const bf16*)(ws + WS_WD2), M, D, DFF, HLD}; pg8::StaticOrder S; S.init(M, D, F.G, bx); S.rev = 1; pg8::EpiBf16<0> E{Fm, D, nullptr, 0, 0, 1.f};
      pg8::gemm_phase<pg8::EpiBf16<0>, pg8::StaticOrder, true, true>(F.lds, g, S, E, F.wave); })
    RUN(13, { row_phase<true, false, true, true>(F, Fm, XB, XB3, 0.5f, F.in[30], F.in[31], XN, nullptr, nullptr); REFRESH();
      { pg8::Gemm g{LA, (const bf16*)(ws + WS_WPP), M, D, DPLE, DPLE}; pg8::StaticOrder S; S.init(M, D, F.G, bx); pg8::EpiBf16<0> E{Tm, D, nullptr, 0, 0, 1.f};
      pg8::gemm_phase<pg8::EpiBf16<0>, pg8::StaticOrder, true, true>(F.lds, g, S, E, F.wave); } })
    RUN(14, { pg8::Gemm g{XN, (const bf16*)(ws + WS_WPG), M, D, D, D}; pg8::StaticOrder S; S.init(M, D, F.G, bx); pg8::EpiPle E{Fm, Tm, D};
      pg8::gemm_phase<pg8::EpiPle, pg8::StaticOrder, true, true>(F.lds, g, S, E, F.wave); })
    row_phase<false, false, true, false>(F, Fm, XB3, F.out, 1.0f, F.in[34], nullptr, nullptr, nullptr, nullptr);
#ifdef TS_PROBE
    grid.sync(); REFRESH();
    if (bx == 0) { const unsigned long long* ts = (const unsigned long long*)(ws + WS_BG + 2 * MiB);
        const int n = (TS_A < 0) ? 2000 : (int)((ts[TS_B] - ts[TS_A]) / 100ull);
        for (int i = F.tid; i < n; i += NTHREADS) F.out[i] += 0.5f;
#ifdef TS_C
        if (F.tid == 0) { const unsigned long long t0 = __builtin_amdgcn_s_memrealtime(), span = (ts[TS_D] - ts[TS_C]) * 4ull;
            while (__builtin_amdgcn_s_memrealtime() - t0 < span) __builtin_amdgcn_s_sleep(8); }
#endif
    }
#endif
}

extern "C" void kernel_launch(void* const* d_in, const int* in_sizes, int n_in, void* d_out, int out_size, void* d_ws, size_t ws_size, hipStream_t stream) {
    static int grid = 0;
    if (grid == 0) {
        if (n_in != 35 || in_sizes[0] != M * D || out_size != M * D || ws_size < WS_END) { fprintf(stderr, "kernel_launch: unexpected shapes: n_in %d in0 %d out %d ws %zu; nothing launched\n", n_in, n_in > 0 ? in_sizes[0] : -1, out_size, ws_size); grid = -1; return; }
        int dev = 0, cus = 0, per_cu = 0;
        hipGetDevice(&dev); hipDeviceGetAttribute(&cus, hipDeviceAttributeMultiprocessorCount, dev);
        if (hipFuncSetAttribute((const void*)mega_fwd, hipFuncAttributeMaxDynamicSharedMemorySize, LDS_BYTES) != hipSuccess) { fprintf(stderr, "kernel_launch: hipFuncSetAttribute failed\n"); grid = -1; return; }
        if (hipOccupancyMaxActiveBlocksPerMultiprocessor(&per_cu, (const void*)mega_fwd, NTHREADS, LDS_BYTES) != hipSuccess || per_cu < 1) { fprintf(stderr, "kernel_launch: occupancy query says %d\n", per_cu); per_cu = 1; }
        (void)hipGetLastError();
        grid = cus;
    }
    if (grid < 0) return;
    Args a{};
    for (int i = 0; i < 35; ++i) a.in[i] = (const float*)d_in[i];
    a.out = (float*)d_out; a.ws = (unsigned char*)d_ws;
    void* kargs[] = {&a};
    hipError_t e = hipLaunchCooperativeKernel((const void*)mega_fwd, dim3(grid), dim3(NTHREADS), kargs, LDS_BYTES, stream);
    if (e != hipSuccess) fprintf(stderr, "kernel_launch: cooperative launch failed: %s (grid %d)\n", hipGetErrorString(e), grid);
}
```
